# Optimizing an MI355X kernel written in HIP

```python
import math
import jax, jax.numpy as jnp
from jax import lax
import numpy as np

D_MODEL = 1024
BATCH = 8
SEQ = 2048
DEPTH = 1

CHUNK = 64
SB_HEADS = 8
SB_HEAD_DIM = 64
SB_WIDTH = SB_HEADS * SB_HEAD_DIM
SB_BLOCK = 128
GLA_HEADS = 4
GLA_KEY_DIM = 64
GLA_VALUE_DIM = 128
GLA_K_WIDTH = GLA_HEADS * GLA_KEY_DIM
GLA_V_WIDTH = GLA_HEADS * GLA_VALUE_DIM
GLA_GATE_RANK = 16
GLA_GATE_TEMP = 16.0
N_BRANCHES = 2
N_EXPERTS = 64
TOP_K = 8
N_GROUPS = 8
TOPK_GROUPS = 4
EXPERT_DIM = 256
SHARED_DIM = 256
ROUTED_SCALE = 2.5
DN_ALPHA = (2 * DEPTH) ** 0.25
DN_BETA = (8 * DEPTH) ** -0.25
LN_EPS = 1e-5
IN_WIDTHS = (SB_WIDTH, SB_WIDTH, SB_WIDTH, GLA_K_WIDTH, GLA_K_WIDTH, GLA_V_WIDTH, GLA_V_WIDTH,
             GLA_GATE_RANK, N_BRANCHES * D_MODEL)
IN_WIDTH = 3 * SB_WIDTH + 2 * GLA_K_WIDTH + 2 * GLA_V_WIDTH + GLA_GATE_RANK + N_BRANCHES * D_MODEL

kernel_name = "hybrid_sb_gla_moe_deepnorm_adaln"


def _split_points():
    pts, acc = [], 0
    for w in IN_WIDTHS[:-1]:
        acc += w
        pts.append(acc)
    return pts


def layer_norm(x, g=None, b=None):
    xf = x.astype(jnp.float32)
    mu = jnp.mean(xf, axis=-1, keepdims=True)
    var = jnp.mean(jnp.square(xf - mu), axis=-1, keepdims=True)
    y = (xf - mu) * lax.rsqrt(var + LN_EPS)
    if g is not None:
        y = y * g.astype(jnp.float32) + b.astype(jnp.float32)
    return y.astype(x.dtype)


def split_heads(t, n_heads):
    b, s, w = t.shape
    return t.reshape(b, s, n_heads, w // n_heads).transpose(0, 2, 1, 3)


def merge_heads(t):
    b, h, s, d = t.shape
    return t.transpose(0, 2, 1, 3).reshape(b, s, h * d)


def stick_breaking_attention(q, k, v):
    q, k, v = (t.astype(jnp.float32) for t in (q, k, v))
    seq = q.shape[2]
    scale = 1.0 / math.sqrt(q.shape[-1])
    outs = []
    for i in range(seq // SB_BLOCK):
        kv_len = (i + 1) * SB_BLOCK
        q_blk = q[:, :, i * SB_BLOCK:kv_len]
        k_blk, v_blk = k[:, :, :kv_len], v[:, :, :kv_len]
        z = jnp.einsum('bhqd,bhkd->bhqk', q_blk, k_blk) * scale
        q_pos = i * SB_BLOCK + jnp.arange(SB_BLOCK)
        k_pos = jnp.arange(kv_len)
        strict = k_pos[None, :] < q_pos[:, None]
        log_beta = jnp.where(strict, jax.nn.log_sigmoid(z), -jnp.inf)
        log_1m = jnp.where(strict, jax.nn.log_sigmoid(-z), 0.0)
        rest = lax.cumsum(log_1m, axis=3, reverse=True) - log_1m
        w = jnp.exp(log_beta + rest)
        outs.append(jnp.einsum('bhqk,bhkd->bhqd', w, v_blk))
    return jnp.concatenate(outs, axis=2)


def gated_linear_attention(q, k, v, log_a):
    q, k, v, log_a = (t.astype(jnp.float32) for t in (q, k, v, log_a))
    b, h, seq, dk = q.shape
    dv = v.shape[-1]
    n_chunks = seq // CHUNK

    def to_chunks(t):
        return jnp.moveaxis(t.reshape(b, h, n_chunks, CHUNK, t.shape[-1]), 2, 0)

    qc, kc, vc = to_chunks(q), to_chunks(k), to_chunks(v)
    gc = jnp.cumsum(to_chunks(log_a), axis=3)
    causal = jnp.tril(jnp.ones((CHUNK, CHUNK), dtype=bool))

    def step(state, inp):
        q_c, k_c, v_c, g_c = inp
        o_inter = jnp.einsum('bhtd,bhdv->bhtv', q_c * jnp.exp(g_c), state)
        diff = g_c[:, :, :, None, :] - g_c[:, :, None, :, :]
        decay = jnp.exp(jnp.where(causal[:, :, None], diff, -jnp.inf))
        scores = jnp.einsum('bhtd,bhsd,bhtsd->bhts', q_c, k_c, decay)
        o_intra = jnp.einsum('bhts,bhsv->bhtv', scores, v_c)
        g_last = g_c[:, :, -1]
        k_dec = k_c * jnp.exp(g_last[:, :, None, :] - g_c)
        state = jnp.exp(g_last)[..., None] * state + jnp.einsum('bhsd,bhsv->bhdv', k_dec, v_c)
        return state, o_inter + o_intra

    s0 = jnp.zeros((b, h, dk, dv), jnp.float32)
    _, o = lax.scan(step, s0, (qc, kc, vc, gc))
    return jnp.moveaxis(o, 0, 2).reshape(b, h, seq, dv)


def token_mixer(h, w_in, gla_w_gate_up, gla_b_gate, gla_norm_w, w_branch_sb, w_branch_gla, w_out):
    proj = h @ w_in
    q_sb, k_sb, v_sb, q_g, k_g, v_g, r_g, g_lr, merge = jnp.split(proj, _split_points(), axis=-1)
    o_sb = merge_heads(stick_breaking_attention(split_heads(q_sb, SB_HEADS), split_heads(k_sb, SB_HEADS),
                                                split_heads(v_sb, SB_HEADS))).astype(h.dtype)
    log_a = jax.nn.log_sigmoid((g_lr @ gla_w_gate_up + gla_b_gate).astype(jnp.float32)) / GLA_GATE_TEMP
    o_g = gated_linear_attention(split_heads(q_g, GLA_HEADS) * (GLA_KEY_DIM ** -0.5),
                                 split_heads(k_g, GLA_HEADS), split_heads(v_g, GLA_HEADS),
                                 split_heads(log_a, GLA_HEADS))
    o_g = o_g * lax.rsqrt(jnp.mean(jnp.square(o_g), axis=-1, keepdims=True) + LN_EPS)
    o_g = (merge_heads(o_g) * gla_norm_w.astype(jnp.float32)).astype(h.dtype) * jax.nn.silu(r_g)
    gate_sb, gate_gla = jnp.split(jax.nn.sigmoid(merge), 2, axis=-1)
    y = gate_sb * (o_sb @ w_branch_sb) + gate_gla * (o_g @ w_branch_gla)
    return y @ w_out


def moe_ffn(h, w_router, router_bias, w_exp_gate_up, w_exp_down, w_shared_gate_up, w_shared_down):
    b, s, d = h.shape
    scores = jax.nn.sigmoid((h @ w_router).astype(jnp.float32))
    sel = scores + router_bias.astype(jnp.float32)
    grp = sel.reshape(b, s, N_GROUPS, N_EXPERTS // N_GROUPS)
    group_score = jnp.sum(lax.top_k(grp, 2)[0], axis=-1)
    _, top_groups = lax.top_k(group_score, TOPK_GROUPS)
    group_mask = jnp.sum(jax.nn.one_hot(top_groups, N_GROUPS, dtype=jnp.float32), axis=-2)
    expert_mask = jnp.repeat(group_mask, N_EXPERTS // N_GROUPS, axis=-1)
    _, idx = lax.top_k(jnp.where(expert_mask > 0, sel, -jnp.inf), TOP_K)
    w = jnp.take_along_axis(scores, idx, axis=-1)
    w = w / jnp.sum(w, axis=-1, keepdims=True) * ROUTED_SCALE
    gates = jnp.sum(jax.nn.one_hot(idx, N_EXPERTS, dtype=jnp.float32) * w[..., None], axis=-2)
    gates = gates.astype(h.dtype)

    def routed_row(args):
        hr, gr = args
        gu = jnp.einsum('td,edf->tef', hr, w_exp_gate_up)
        g_part, u_part = jnp.split(gu, 2, axis=-1)
        act = jax.nn.silu(g_part) * u_part * gr[..., None]
        return jnp.einsum('tef,efd->td', act, w_exp_down)

    routed = lax.map(routed_row, (h, gates))
    sg, su = jnp.split(h @ w_shared_gate_up, 2, axis=-1)
    shared = (jax.nn.silu(sg) * su) @ w_shared_down
    return routed + shared


def setup_inputs(seed: int = 0) -> dict:
    key = jax.random.key(seed)
    ks = jax.random.split(key, 24)

    def nrm(k, shape, scale):
        return jax.random.normal(k, shape, jnp.float32) * scale

    L, D, E = DEPTH, D_MODEL, N_EXPERTS
    return {
        "x": nrm(ks[0], (BATCH, SEQ, D), 1.0),
        "c": nrm(ks[1], (BATCH, D), 1.0),
        "w_ada": nrm(ks[2], (L, D, 6 * D), 0.5 * D ** -0.5),
        "b_ada": nrm(ks[3], (L, 6 * D), 0.02),
        "w_in": nrm(ks[4], (L, D, IN_WIDTH), D ** -0.5),
        "gla_w_gate_up": nrm(ks[5], (L, GLA_GATE_RANK, GLA_K_WIDTH), GLA_GATE_RANK ** -0.5),
        "gla_b_gate": 1.0 + nrm(ks[6], (L, GLA_K_WIDTH), 0.1),
        "gla_norm_w": 1.0 + nrm(ks[7], (L, GLA_V_WIDTH), 0.02),
        "w_branch_sb": nrm(ks[8], (L, SB_WIDTH, D), SB_WIDTH ** -0.5),
        "w_branch_gla": nrm(ks[9], (L, GLA_V_WIDTH, D), GLA_V_WIDTH ** -0.5),
        "w_out": nrm(ks[10], (L, D, D), DN_BETA * D ** -0.5),
        "ln1_g": 1.0 + nrm(ks[11], (L, D), 0.02),
        "ln1_b": nrm(ks[12], (L, D), 0.02),
        "w_router": nrm(ks[13], (L, D, E), D ** -0.5),
        "router_bias": nrm(ks[14], (L, E), 0.01),
        "w_exp_gate_up": nrm(ks[15], (L, E, D, 2 * EXPERT_DIM), D ** -0.5),
        "w_exp_down": nrm(ks[16], (L, E, EXPERT_DIM, D), DN_BETA * EXPERT_DIM ** -0.5),
        "w_shared_gate_up": nrm(ks[17], (L, D, 2 * SHARED_DIM), D ** -0.5),
        "w_shared_down": nrm(ks[18], (L, SHARED_DIM, D), DN_BETA * SHARED_DIM ** -0.5),
        "ln2_g": 1.0 + nrm(ks[19], (L, D), 0.02),
        "ln2_b": nrm(ks[20], (L, D), 0.02),
    }


def reference(x, c, w_ada, b_ada, w_in, gla_w_gate_up, gla_b_gate, gla_norm_w, w_branch_sb, w_branch_gla,
              w_out, ln1_g, ln1_b, w_router, router_bias, w_exp_gate_up, w_exp_down, w_shared_gate_up,
              w_shared_down, ln2_g, ln2_b):
    for l in range(DEPTH):
        mod = jax.nn.silu(c) @ w_ada[l] + b_ada[l]
        shift1, scale1, gate1, shift2, scale2, gate2 = (m[:, None, :] for m in jnp.split(mod, 6, axis=-1))
        h = layer_norm(x) * (1.0 + scale1) + shift1
        mix = token_mixer(h, w_in[l], gla_w_gate_up[l], gla_b_gate[l], gla_norm_w[l],
                          w_branch_sb[l], w_branch_gla[l], w_out[l])
        x = layer_norm(DN_ALPHA * x + gate1 * mix, ln1_g[l], ln1_b[l])
        h = layer_norm(x) * (1.0 + scale2) + shift2
        ffn = moe_ffn(h, w_router[l], router_bias[l], w_exp_gate_up[l], w_exp_down[l],
                      w_shared_gate_up[l], w_shared_down[l])
        x = layer_norm(DN_ALPHA * x + gate2 * ffn, ln2_g[l], ln2_b[l])
    return x
```

```cpp
#include <hip/hip_runtime.h>
#include <hip/hip_cooperative_groups.h>
#include <cstdio>
#include <cstdint>
namespace cg = cooperative_groups;

#define LAS __attribute__((address_space(3)))
#define GAS __attribute__((address_space(1)))
typedef unsigned short bf16_t;
typedef short bf16x8 __attribute__((ext_vector_type(8)));
typedef short bf16x4 __attribute__((ext_vector_type(4)));
typedef float f32x4 __attribute__((ext_vector_type(4)));
typedef float f32x16 __attribute__((ext_vector_type(16)));
typedef unsigned u32x4 __attribute__((ext_vector_type(4)));
typedef unsigned u32x2 __attribute__((ext_vector_type(2)));

#define LDS_WAIT() asm volatile("s_waitcnt lgkmcnt(0)" ::: "memory")
#define VM_WAIT() asm volatile("s_waitcnt vmcnt(0)" ::: "memory")

__device__ __forceinline__ unsigned f2bf(float f) { unsigned u = __builtin_bit_cast(unsigned, f); return (u + 0x7fffu + ((u >> 16) & 1u)) >> 16; }
__device__ __forceinline__ unsigned pk2(float lo, float hi) { return f2bf(lo) | (f2bf(hi) << 16); }
__device__ __forceinline__ float bf2f(unsigned short b) { return __builtin_bit_cast(float, (unsigned)b << 16); }
__device__ __forceinline__ float bflo(unsigned w) { return __builtin_bit_cast(float, w << 16); }
__device__ __forceinline__ float bfhi(unsigned w) { return __builtin_bit_cast(float, w & 0xffff0000u); }
__device__ __forceinline__ float fexp(float x) { return __builtin_amdgcn_exp2f(x * 1.4426950408889634f); }
__device__ __forceinline__ float flog(float x) { return __builtin_amdgcn_logf(x) * 0.6931471805599453f; }
__device__ __forceinline__ float sigmoidf_(float x) { return __builtin_amdgcn_rcpf(1.0f + fexp(-x)); }
__device__ __forceinline__ float logsigmoid_(float x) { return fminf(x, 0.f) - flog(1.0f + fexp(-fabsf(x))); }
__device__ __forceinline__ float wave_sum(float v) {
#pragma unroll
    for (int o = 1; o < 64; o <<= 1) v += __shfl_xor(v, o);
    return v;
}

constexpr int NTOK = 16384, DM = 1024, SEQ = 2048, NB = 8;
constexpr int PW = 4096;
constexpr int C_QSB = 0, C_KSB = 512, C_QG = 1024, C_KG = 1280, C_RG = 1536, C_MG = 2048;
constexpr int NEXP = 64, ECAP = 16384;
constexpr float LN_EPS = 1e-5f;
constexpr float DN_ALPHA = 1.189207115002721f;
constexpr float ROUTED_SCALE = 2.5f;

constexpr size_t MiB = 1u << 20;
constexpr size_t WS_CTL = 0, CTL_ZERO_BYTES = 1 * MiB;
constexpr size_t WS_MOD = 1 * MiB;
constexpr size_t WS_GLR = 2 * MiB;
constexpr size_t WS_DEC = 3 * MiB;
constexpr size_t WS_SLOT = 4 * MiB;
constexpr size_t WS_LIST = 6 * MiB;
constexpr size_t WS_GWT = 10 * MiB;
constexpr size_t WS_WSM = 14 * MiB;
constexpr size_t WS_WSB = 15 * MiB, WS_WGLA = 16 * MiB, WS_WOUT = 17 * MiB;
constexpr size_t WS_WIN = 19 * MiB;
constexpr size_t WS_WV = 27 * MiB;
constexpr size_t WS_WDN = 29 * MiB;
constexpr size_t WS_WGU = 62 * MiB;
constexpr size_t WS_H1 = 127 * MiB;
constexpr size_t WS_PROJ = 159 * MiB;
constexpr size_t WS_VT = 319 * MiB;
constexpr size_t WS_OSB = 351 * MiB, WS_OG = 367 * MiB;
constexpr size_t WS_Y = 383 * MiB;
constexpr size_t WS_KVT = 415 * MiB;
constexpr size_t WS_ST16 = 447 * MiB;
constexpr size_t WS_H2 = 463 * MiB;
constexpr size_t WS_ACT = 127 * MiB;
constexpr size_t WS_YS = 207 * MiB;
constexpr size_t WS_END = 495 * MiB;
constexpr int CW_CNT = 64;
constexpr int CW_BAR = 4096;

namespace pg8 {
constexpr int BM = 256, BK = 64, HALF = 128, HTB = HALF * BK * 2, STAGE_BYTES = 8 * HTB, NXCD = 8, WGM = 8;
__host__ __device__ __forceinline__ int lds_byte(int r, int c) { const int st = (r >> 4) * 2 + (c >> 5), rr = r & 15, cc = c & 31, ob = rr * 64 + cc * 2; return st * 1024 + (ob ^ (((ob >> 9) & 1) << 5)); }
__host__ __device__ __forceinline__ void stage_rc(int b, int& R, int& C) { const int st = b / 1024, sb = b % 1024, swz = sb ^ (((sb >> 9) & 1) << 5); R = (st >> 1) * 16 + swz / 64; C = (st & 1) * 32 + (swz % 64) / 2; }
__host__ __device__ __forceinline__ int perm32(int rho) { const int n = rho >> 4, i = rho & 15; return 8 * (i >> 2) + 4 * n + (i & 3); }

struct Unit { int pm, pn; };
struct Gemm { const bf16_t* A; const bf16_t* Bt; int M, N, K; };

struct StaticOrder {
    int nM, nN, nwg, G, c;
    __host__ __device__ void init(int M, int N, int G_, int c_) { nM = M / BM; nN = N / BM; nwg = nM * nN; G = G_; c = c_; }
    __host__ __device__ bool next(int i, Unit& u) const {
        const long L = (long)i * G + c; if (L >= nwg) return false;
        int wgid = (int)L; { const int q = nwg / NXCD, r = nwg % NXCD, xcd = wgid % NXCD, off = wgid / NXCD; wgid = (xcd < r ? xcd * (q + 1) : r * (q + 1) + (xcd - r) * q) + off; }
        const int nig = WGM * nN, gid = wgid / nig, fm = gid * WGM, gsz = (nM - fm) < WGM ? (nM - fm) : WGM;
        u.pm = fm + ((wgid % nig) % gsz); u.pn = (wgid % nig) / gsz; return true;
    }
};
struct MoeOrder {
    int nunits, nN, G, c; const LAS int* tile_e;
    __device__ __forceinline__ bool next(int i, Unit& u) const {
        const long L = (long)i * G + c; if (L >= nunits) return false;
        const int tile = (int)L / nN, pnl = (int)L % nN;
        const int e = __builtin_amdgcn_readfirstlane(tile_e[tile]);
        u.pm = tile; u.pn = e * nN + pnl; return true;
    }
};
struct NoGather { static constexpr bool ON = false; __device__ __forceinline__ unsigned row(const Unit&, int) const { return 0u; } };

template <class Epi, class Sched, bool ALIGN_EPI, class Gath>
__device__ __forceinline__ void gemm_phase(LAS unsigned char* lds, const Gemm g, const Sched& S, const Epi& E, const Gath& GA) {
    const int tid = threadIdx.x, wid = __builtin_amdgcn_readfirstlane(tid >> 6), lane = tid & 63, wr = wid >> 2, wc = wid & 3, fr = lane & 15, fq = lane >> 4;
    const int K = g.K, nt = K / BK;
    unsigned voffA[2], voffB[2]; int RA[2], CA2[2];
#pragma unroll
    for (int i = 0; i < 2; ++i) { int R, C; stage_rc(tid * 16 + i * 8192, R, C); const int Rb = Epi::PERM ? ((R & ~31) + perm32(R & 31)) : R;
        voffA[i] = (unsigned)(R * K + C) * 2u; voffB[i] = (unsigned)(Rb * K + C) * 2u; RA[i] = R; CA2[i] = C * 2; }
    const size_t kstep = (size_t)(BK * 2);
    const size_t hstep = (size_t)HALF * K * 2;
    const size_t tstep = 2 * hstep;
    const size_t hstepA = Gath::ON ? 0 : hstep;
    const unsigned ldsw = (unsigned)wid * 1024u;
    const int aoff = lds_byte(wr * 64 + fr, fq * 8), boff = lds_byte(wc * 32 + fr, fq * 8);
#define PG8_SA(b, h) (((b) * 2 + (h)) * HTB)
#define PG8_SB(b, h) ((4 + (b) * 2 + (h)) * HTB)
#define PG8_STAGE(bufoff, gbase, voff) do { _Pragma("unroll") for (int _i = 0; _i < 2; ++_i) \
        __builtin_amdgcn_global_load_lds((const unsigned*)((const char*)(gbase) + (voff)[_i]), (LAS unsigned*)(lds + (bufoff) + ldsw + _i * 8192), 16, 0, 0); } while (0)
#define PG8_STAGE_A(bufoff, gbase, h, usenext) do { if constexpr (Gath::ON) { unsigned _o[2]; _o[0] = (usenext) ? gan[h][0] : gac[h][0]; _o[1] = (usenext) ? gan[h][1] : gac[h][1]; PG8_STAGE(bufoff, gbase, _o); } \
        else { PG8_STAGE(bufoff, (gbase) + (h) * hstepA, voffA); } } while (0)
#define PG8_LDA(dst, b, h) do { _Pragma("unroll") for (int m = 0; m < 4; ++m) _Pragma("unroll") for (int k = 0; k < 2; ++k) dst[m][k] = *(const LAS bf16x8*)(lds + PG8_SA(b, h) + aoff + m * 2048 + k * 1024); } while (0)
#define PG8_LDB(dst, b, h) do { _Pragma("unroll") for (int n = 0; n < 2; ++n) _Pragma("unroll") for (int k = 0; k < 2; ++k) dst[n][k] = *(const LAS bf16x8*)(lds + PG8_SB(b, h) + boff + n * 2048 + k * 1024); } while (0)
#define PG8_MMA(ai, bj, At, Bt) do { __builtin_amdgcn_s_setprio(1); _Pragma("unroll") for (int m = 0; m < 4; ++m) _Pragma("unroll") for (int n = 0; n < 2; ++n) _Pragma("unroll") for (int k = 0; k < 2; ++k) \
        acc[ai][bj][m][n] = __builtin_amdgcn_mfma_f32_16x16x32_bf16(Bt[n][k], At[m][k], acc[ai][bj][m][n], 0, 0, 0); __builtin_amdgcn_s_setprio(0); } while (0)
#define PG8_WAIT_V(n) asm volatile("s_waitcnt vmcnt(" #n ")" ::: "memory")
#define PG8_WAIT_L(n) asm volatile("s_waitcnt lgkmcnt(" #n ")" ::: "memory")
#define PG8_BAR __builtin_amdgcn_s_barrier()
#define PG8_SCHED __builtin_amdgcn_sched_barrier(0)
    Unit cur, nxt; int ui = 0;
    if (!S.next(0, cur)) return;
    f32x4 acc[2][2][4][2];
#pragma unroll
    for (int a = 0; a < 2; ++a)
#pragma unroll
        for (int b = 0; b < 2; ++b)
#pragma unroll
            for (int m = 0; m < 4; ++m)
#pragma unroll
                for (int n = 0; n < 2; ++n) acc[a][b][m][n] = (f32x4){0.f, 0.f, 0.f, 0.f};
    bf16x8 At[4][2], B0[2][2], B1[2][2];
    unsigned gac[2][2], gan[2][2];
    if constexpr (Gath::ON) {
#pragma unroll
        for (int h = 0; h < 2; ++h)
#pragma unroll
            for (int i = 0; i < 2; ++i) { gac[h][i] = GA.row(cur, h * HALF + RA[i]) * (unsigned)(K * 2) + (unsigned)CA2[i]; gan[h][i] = gac[h][i]; }
    }
    const char* cA = (const char*)g.A + (Gath::ON ? (size_t)0 : (size_t)cur.pm * tstep); const char* cB = (const char*)g.Bt + (size_t)cur.pn * tstep;
    PG8_STAGE(PG8_SB(0, 0), cB, voffB); PG8_STAGE(PG8_SB(0, 1), cB + hstep, voffB); PG8_STAGE_A(PG8_SA(0, 0), cA, 0, false); PG8_STAGE_A(PG8_SA(0, 1), cA, 1, false);
    if (wr == 1) PG8_BAR;
    PG8_WAIT_V(2); PG8_BAR;
    PG8_STAGE(PG8_SB(1, 0), cB + kstep, voffB); PG8_STAGE_A(PG8_SA(1, 0), cA + kstep, 0, false); PG8_STAGE(PG8_SB(1, 1), cB + hstep + kstep, voffB);
    PG8_WAIT_V(6); PG8_BAR;
    for (;;) {
        const bool has_next = S.next(ui + 1, nxt);
        const char* nA = (has_next && !Gath::ON) ? (const char*)g.A + (size_t)nxt.pm * tstep : cA; const char* nB = has_next ? (const char*)g.Bt + (size_t)nxt.pn * tstep : cB;
        if constexpr (Gath::ON) {
            if (has_next) {
#pragma unroll
                for (int h = 0; h < 2; ++h)
#pragma unroll
                    for (int i = 0; i < 2; ++i) gan[h][i] = GA.row(nxt, h * HALF + RA[i]) * (unsigned)(K * 2) + (unsigned)CA2[i];
            }
        }
        for (int t = 0; t < nt; t += 2) {
            const bool last = (t == nt - 2);
            const char* a1 = cA + (size_t)(t + 1) * kstep;
            const char* a2 = last ? nA : cA + (size_t)(t + 2) * kstep; const char* b2 = last ? nB : cB + (size_t)(t + 2) * kstep;
            const char* a3 = a2 + kstep; const char* b3 = b2 + kstep;
            PG8_LDB(B0, 0, 0); PG8_LDB(B1, 0, 1); PG8_SCHED; PG8_LDA(At, 0, 0); PG8_STAGE_A(PG8_SA(1, 1), a1, 1, false);
            PG8_WAIT_V(8); PG8_WAIT_L(0); PG8_BAR; PG8_MMA(0, 0, At, B0); PG8_MMA(0, 1, At, B1); PG8_BAR; PG8_SCHED;
            PG8_LDA(At, 0, 1); PG8_STAGE(PG8_SB(0, 0), b2, voffB); PG8_STAGE(PG8_SB(0, 1), b2 + hstep, voffB); PG8_STAGE_A(PG8_SA(0, 0), a2, 0, last);
            PG8_WAIT_V(8); PG8_WAIT_L(0); PG8_BAR; PG8_MMA(1, 0, At, B0); PG8_MMA(1, 1, At, B1); PG8_BAR; PG8_SCHED;
            PG8_LDB(B0, 1, 0); PG8_LDB(B1, 1, 1); PG8_SCHED; PG8_LDA(At, 1, 0); PG8_STAGE_A(PG8_SA(0, 1), a2, 1, last);
            PG8_WAIT_V(8); PG8_WAIT_L(0); PG8_BAR; PG8_MMA(0, 0, At, B0); PG8_MMA(0, 1, At, B1); PG8_BAR; PG8_SCHED;
            PG8_LDA(At, 1, 1); PG8_STAGE(PG8_SB(1, 0), b3, voffB); PG8_STAGE(PG8_SB(1, 1), b3 + hstep, voffB); PG8_STAGE_A(PG8_SA(1, 0), a3, 0, last);
            PG8_WAIT_V(8); PG8_WAIT_L(0); PG8_BAR; PG8_MMA(1, 0, At, B0); PG8_MMA(1, 1, At, B1); PG8_BAR; PG8_SCHED;
        }
        if constexpr (ALIGN_EPI) { if (wr == 0) PG8_BAR; }
        E(acc, cur, wr, wc, fr, fq);
        if (!has_next) break;
#pragma unroll
        for (int a = 0; a < 2; ++a)
#pragma unroll
            for (int b = 0; b < 2; ++b)
#pragma unroll
                for (int m = 0; m < 4; ++m)
#pragma unroll
                    for (int n = 0; n < 2; ++n) acc[a][b][m][n] = (f32x4){0.f, 0.f, 0.f, 0.f};
        cur = nxt; cA = nA; cB = nB; ++ui;
        if constexpr (Gath::ON) {
#pragma unroll
            for (int h = 0; h < 2; ++h)
#pragma unroll
                for (int i = 0; i < 2; ++i) gac[h][i] = gan[h][i];
        }
        if constexpr (ALIGN_EPI) { if (wr == 1) PG8_BAR; }
    }
    PG8_WAIT_V(0);
    if constexpr (!ALIGN_EPI) { if (wr == 0) PG8_BAR; }
    PG8_BAR;
#undef PG8_SA
#undef PG8_SB
#undef PG8_STAGE
#undef PG8_STAGE_A
#undef PG8_LDA
#undef PG8_LDB
#undef PG8_MMA
#undef PG8_WAIT_V
#undef PG8_WAIT_L
#undef PG8_BAR
#undef PG8_SCHED
}
}
namespace pg8 {
typedef const f32x4 (&AccRef)[2][2][4][2];

struct EpiStore {
    static constexpr bool PERM = true;
    bf16_t* o; int ldc;
    __device__ __forceinline__ void operator()(AccRef acc, const Unit& u, int wr, int wc, int fr, int fq) const {
        const int row0 = u.pm * BM + wr * 64 + fr, col0 = u.pn * BM + wc * 32 + 8 * fq;
#pragma unroll
        for (int ai = 0; ai < 2; ++ai)
#pragma unroll
            for (int m = 0; m < 4; ++m) { bf16_t* rowp = o + (size_t)(row0 + ai * HALF + m * 16) * ldc + col0;
#pragma unroll
                for (int bj = 0; bj < 2; ++bj) { const f32x4 v0 = acc[ai][bj][m][0], v1 = acc[ai][bj][m][1];
                    u32x4 w; w.x = pk2(v0[0], v0[1]); w.y = pk2(v0[2], v0[3]); w.z = pk2(v1[0], v1[1]); w.w = pk2(v1[2], v1[3]);
                    *(u32x4*)(rowp + bj * HALF) = w; } }
    }
};
struct EpiVT {
    static constexpr bool PERM = true;
    bf16_t* vt;
    __device__ __forceinline__ void operator()(AccRef acc, const Unit& u, int wr, int wc, int fr, int fq) const {
        const int row0 = u.pm * BM + wr * 64 + fr, b = u.pn >> 3, t0 = (u.pn & 7) * BM + wc * 32 + 8 * fq;
#pragma unroll
        for (int ai = 0; ai < 2; ++ai)
#pragma unroll
            for (int m = 0; m < 4; ++m) { bf16_t* rowp = vt + ((size_t)b * 1024 + row0 + ai * HALF + m * 16) * SEQ + t0;
#pragma unroll
                for (int bj = 0; bj < 2; ++bj) { const f32x4 v0 = acc[ai][bj][m][0], v1 = acc[ai][bj][m][1];
                    u32x4 w; w.x = pk2(v0[0], v0[1]); w.y = pk2(v0[2], v0[3]); w.z = pk2(v1[0], v1[1]); w.w = pk2(v1[2], v1[3]);
                    *(u32x4*)(rowp + bj * HALF) = w; } }
    }
};

template <int PASS> struct EpiBranch {
    static constexpr bool PERM = true;
    const bf16_t* proj; bf16_t* y;
    __device__ __forceinline__ void operator()(AccRef acc, const Unit& u, int wr, int wc, int fr, int fq) const {
        const int row0 = u.pm * BM + wr * 64 + fr, col0 = u.pn * BM + wc * 32 + 8 * fq;
#pragma unroll
        for (int ai = 0; ai < 2; ++ai)
#pragma unroll
            for (int m = 0; m < 4; ++m) { const size_t row = (size_t)(row0 + ai * HALF + m * 16);
#pragma unroll
                for (int bj = 0; bj < 2; ++bj) {
                    const int col = col0 + bj * HALF;
                    const u32x4 g = *(const u32x4*)(proj + row * PW + C_MG + (PASS == 1 ? 0 : 1024) + col);
                    const f32x4 v0 = acc[ai][bj][m][0], v1 = acc[ai][bj][m][1];
                    float o[8];
                    o[0] = sigmoidf_(bflo(g.x)) * v0[0]; o[1] = sigmoidf_(bfhi(g.x)) * v0[1]; o[2] = sigmoidf_(bflo(g.y)) * v0[2]; o[3] = sigmoidf_(bfhi(g.y)) * v0[3];
                    o[4] = sigmoidf_(bflo(g.z)) * v1[0]; o[5] = sigmoidf_(bfhi(g.z)) * v1[1]; o[6] = sigmoidf_(bflo(g.w)) * v1[2]; o[7] = sigmoidf_(bfhi(g.w)) * v1[3];
                    bf16_t* yp = y + row * DM + col;
                    if (PASS == 2) { const u32x4 p = *(const u32x4*)yp;
                        o[0] += bflo(p.x); o[1] += bfhi(p.x); o[2] += bflo(p.y); o[3] += bfhi(p.y); o[4] += bflo(p.z); o[5] += bfhi(p.z); o[6] += bflo(p.w); o[7] += bfhi(p.w); }
                    u32x4 w; w.x = pk2(o[0], o[1]); w.y = pk2(o[2], o[3]); w.z = pk2(o[4], o[5]); w.w = pk2(o[6], o[7]);
                    *(u32x4*)yp = w; } }
    }
};

struct EpiOut {
    static constexpr bool PERM = false;
    const float* x; const float* mod; float* pre;
    __device__ __forceinline__ void operator()(AccRef acc, const Unit& u, int wr, int wc, int fr, int fq) const {
        const int row0 = u.pm * BM + wr * 64 + fr, col0 = u.pn * BM + wc * 32 + 4 * fq;
        const int b = (u.pm * BM) >> 11;
        f32x4 gv[2][2];
#pragma unroll
        for (int bj = 0; bj < 2; ++bj)
#pragma unroll
            for (int n = 0; n < 2; ++n) gv[bj][n] = *(const f32x4*)(mod + b * 6144 + 2 * DM + col0 + bj * HALF + n * 16);
#pragma unroll
        for (int ai = 0; ai < 2; ++ai)
#pragma unroll
            for (int m = 0; m < 4; ++m) { const size_t off = (size_t)(row0 + ai * HALF + m * 16) * DM + col0;
#pragma unroll
                for (int bj = 0; bj < 2; ++bj)
#pragma unroll
                    for (int n = 0; n < 2; ++n) { const f32x4 xv = *(const f32x4*)(x + off + bj * HALF + n * 16);
                        *(f32x4*)(pre + off + bj * HALF + n * 16) = xv * DN_ALPHA + gv[bj][n] * acc[ai][bj][m][n]; } }
    }
};

struct MoeTab { const LAS int* tile_e; const LAS int* tile_p0; const LAS int* cnt; const LAS int* yoff; };

struct MoeGather {
    static constexpr bool ON = true;
    MoeTab tb; const int* list;
    __device__ __forceinline__ unsigned row(const Unit& u, int r) const {
        const int e = tb.tile_e[u.pm], p = tb.tile_p0[u.pm] + r;
        if (e == NEXP) return (unsigned)p;
        return (p < tb.cnt[e]) ? (unsigned)list[(size_t)e * ECAP + p] : 0u;
    }
};

struct EpiMoe1 {
    static constexpr bool PERM = true;
    MoeTab tb; const float* gwt; bf16_t* act;
    __device__ __forceinline__ void operator()(AccRef acc, const Unit& u, int wr, int wc, int fr, int fq) const {
        const int e = tb.tile_e[u.pm], p0 = tb.tile_p0[u.pm], cnt = (e == NEXP) ? NTOK : tb.cnt[e];
        const int pnl = u.pn & 1;
        const int r0 = wr * 64 + fr, colo = pnl * 128 + wc * 32 + 8 * fq;
#pragma unroll
        for (int ai = 0; ai < 2; ++ai)
#pragma unroll
            for (int m = 0; m < 4; ++m) { const int r = r0 + ai * HALF + m * 16, p = p0 + r;
                float gw = 1.0f; if (e != NEXP) gw = (p < cnt) ? gwt[(size_t)e * ECAP + p] : 0.f;
                const f32x4 g0 = acc[ai][0][m][0], g1 = acc[ai][0][m][1], u0 = acc[ai][1][m][0], u1 = acc[ai][1][m][1];
                float o[8];
#pragma unroll
                for (int j = 0; j < 4; ++j) { o[j] = g0[j] * sigmoidf_(g0[j]) * u0[j] * gw; o[4 + j] = g1[j] * sigmoidf_(g1[j]) * u1[j] * gw; }
                u32x4 w; w.x = pk2(o[0], o[1]); w.y = pk2(o[2], o[3]); w.z = pk2(o[4], o[5]); w.w = pk2(o[6], o[7]);
                *(u32x4*)(act + ((size_t)u.pm * BM + r) * 256 + colo) = w; }
    }
};

struct EpiMoe2 {
    static constexpr bool PERM = true;
    MoeTab tb; bf16_t* ys;
    __device__ __forceinline__ void operator()(AccRef acc, const Unit& u, int wr, int wc, int fr, int fq) const {
        const int e = tb.tile_e[u.pm], p0 = tb.tile_p0[u.pm], cnt = (e == NEXP) ? NTOK : tb.cnt[e];
        const int yb = (e == NEXP) ? NTOK * 8 : tb.yoff[e];
        const int pnl = u.pn & 3;
        const int r0 = wr * 64 + fr, col0 = pnl * BM + wc * 32 + 8 * fq;
#pragma unroll
        for (int ai = 0; ai < 2; ++ai)
#pragma unroll
            for (int m = 0; m < 4; ++m) { const int p = p0 + r0 + ai * HALF + m * 16;
                if (p < cnt) { bf16_t* rowp = ys + (size_t)(yb + p) * DM + col0;
#pragma unroll
                    for (int bj = 0; bj < 2; ++bj) { const f32x4 v0 = acc[ai][bj][m][0], v1 = acc[ai][bj][m][1];
                        u32x4 w; w.x = pk2(v0[0], v0[1]); w.y = pk2(v0[2], v0[3]); w.z = pk2(v1[0], v1[1]); w.w = pk2(v1[2], v1[3]);
                        *(u32x4*)(rowp + bj * HALF) = w; } } }
    }
};
}
constexpr int NWAVES = 8, NTHR = 512;
constexpr int RING_BYTES = 131072, TAB_OFF = RING_BYTES, LDS_BYTES = 147456;
constexpr int NPHASE = 12;

struct Args {
    const float *x, *c, *w_ada, *b_ada, *w_in, *w_gup, *b_gate, *norm_w, *w_bsb, *w_bgla, *w_out, *ln1_g, *ln1_b, *w_router, *r_bias, *w_egu, *w_edn, *w_sgu, *w_sdn, *ln2_g, *ln2_b;
    float* out; unsigned char* ws; int ph_lo, ph_hi;
};

struct Frame { LAS unsigned char* lds; int tid, lane, wave, G, bid; };

template <class RowMap>
__device__ __forceinline__ void transpose_item(const float* W, int K, int N, LAS float* scr, int item, int lane, const RowMap& rm) {
    const int nblk = (N + 31) / 32, kb = item / nblk, nb = item % nblk, k0 = 64 * kb, n0 = 32 * nb;
    const int nl = lane & 31; const bool cv = (n0 + nl) < N;
#pragma unroll 8
    for (int i = 0; i < 32; ++i) { const int kk = 2 * i + (lane >> 5); scr[kk * 33 + nl] = cv ? W[(size_t)(k0 + kk) * N + n0 + nl] : 0.f; }
    LDS_WAIT(); asm volatile("" ::: "memory");
    const int c = lane & 7;
#pragma unroll
    for (int j = 0; j < 4; ++j) { const int n = (lane >> 3) + 8 * j; const LAS float* s = scr + (8 * c) * 33 + n;
        if (n0 + n < N) { bf16_t* dst = rm(n0 + n);
            u32x4 o; o.x = pk2(s[0 * 33], s[1 * 33]); o.y = pk2(s[2 * 33], s[3 * 33]); o.z = pk2(s[4 * 33], s[5 * 33]); o.w = pk2(s[6 * 33], s[7 * 33]);
            *(u32x4*)(dst + k0 + 8 * c) = o; } }
    LDS_WAIT(); asm volatile("" ::: "memory");
}
struct RmPlain { bf16_t* d; int K; __device__ __forceinline__ bf16_t* operator()(int n) const { return d + (size_t)n * K; } };
struct RmWin { bf16_t* win; bf16_t* wglr; bf16_t* wv; __device__ __forceinline__ bf16_t* operator()(int n) const {
    if (n < 1024) return win + (size_t)n * DM;
    if (n < 1536) return wv + (size_t)(n - 1024) * DM;
    if (n < 2048) return win + (size_t)(n - 512) * DM;
    if (n < 2560) return wv + (size_t)(n - 2048 + 512) * DM;
    if (n < 3072) return win + (size_t)(n - 1024) * DM;
    if (n < 3088) return wglr + (size_t)(n - 3072) * DM;
    return win + (size_t)(n - 3088 + 2048) * DM; } };
struct RmGu { bf16_t* d; __device__ __forceinline__ bf16_t* operator()(int n) const {
    const int r = n < 256 ? ((n >> 7) * 256 + (n & 127)) : (((n - 256) >> 7) * 256 + 128 + ((n - 256) & 127)); return d + (size_t)r * DM; } };

__device__ __forceinline__ void p0_phase(Frame& F, const Args& a) {
    unsigned char* ws = a.ws;
    if (F.bid < 96) {
        LAS float* sc = (LAS float*)F.lds;
        LAS float* red = (LAS float*)(F.lds + 32768);
        for (int i = F.tid; i < NB * DM; i += NTHR) { const float v = a.c[i]; sc[i] = v * sigmoidf_(v); }
        __syncthreads();
        const int col = F.bid * 64 + (F.tid & 63), kg = F.tid >> 6;
        float acc[8];
#pragma unroll
        for (int b = 0; b < 8; ++b) acc[b] = 0.f;
        for (int k = kg * 128; k < kg * 128 + 128; ++k) { const float w = a.w_ada[(size_t)k * 6144 + col];
#pragma unroll
            for (int b = 0; b < 8; ++b) acc[b] += sc[b * DM + k] * w; }
#pragma unroll
        for (int b = 0; b < 8; ++b) red[(kg * 8 + b) * 64 + (F.tid & 63)] = acc[b];
        __syncthreads();
        { const int b = F.tid >> 6, cl = F.tid & 63; float s = a.b_ada[F.bid * 64 + cl];
#pragma unroll
          for (int g = 0; g < 8; ++g) s += red[(g * 8 + b) * 64 + cl];
          ((float*)(ws + WS_MOD))[b * 6144 + F.bid * 64 + cl] = s; }
        __syncthreads();
    }
    LAS float* scr = (LAS float*)(F.lds + F.wave * 16384);
    const int gw = F.bid * NWAVES + F.wave, NGW = F.G * NWAVES;
    bf16_t* WIN = (bf16_t*)(ws + WS_WIN); bf16_t* WGLR = (bf16_t*)(ws + WS_WSM); bf16_t* WR = (bf16_t*)(ws + WS_WSM + 65536);
    bf16_t* WGU = (bf16_t*)(ws + WS_WGU); bf16_t* WDN = (bf16_t*)(ws + WS_WDN);
    constexpr int I_IN = 16 * 161, I_B = 8 * 32, I_O = 16 * 32, I_R = 16 * 2, I_GU1 = 16 * 16, I_GU = 64 * I_GU1, I_DN1 = 4 * 32, I_DN = 64 * I_DN1;
    constexpr int NITEMS = I_IN + 2 * I_B + I_O + I_R + I_GU + I_GU1 + I_DN + I_DN1;
    for (int it = gw; it < NITEMS; it += NGW) {
        int r = it;
        if (r < I_IN) { transpose_item(a.w_in, DM, 5136, scr, r, F.lane, RmWin{WIN, WGLR, (bf16_t*)(ws + WS_WV)}); continue; } r -= I_IN;
        if (r < I_B) { transpose_item(a.w_bsb, 512, DM, scr, r, F.lane, RmPlain{(bf16_t*)(ws + WS_WSB), 512}); continue; } r -= I_B;
        if (r < I_B) { transpose_item(a.w_bgla, 512, DM, scr, r, F.lane, RmPlain{(bf16_t*)(ws + WS_WGLA), 512}); continue; } r -= I_B;
        if (r < I_O) { transpose_item(a.w_out, DM, DM, scr, r, F.lane, RmPlain{(bf16_t*)(ws + WS_WOUT), DM}); continue; } r -= I_O;
        if (r < I_R) { transpose_item(a.w_router, DM, 64, scr, r, F.lane, RmPlain{WR, DM}); continue; } r -= I_R;
        if (r < I_GU) { const int e = r / I_GU1; transpose_item(a.w_egu + (size_t)e * DM * 512, DM, 512, scr, r % I_GU1, F.lane, RmGu{WGU + (size_t)e * 512 * DM}); continue; } r -= I_GU;
        if (r < I_GU1) { transpose_item(a.w_sgu, DM, 512, scr, r, F.lane, RmGu{WGU + (size_t)64 * 512 * DM}); continue; } r -= I_GU1;
        if (r < I_DN) { const int e = r / I_DN1; transpose_item(a.w_edn + (size_t)e * 256 * DM, 256, DM, scr, r % I_DN1, F.lane, RmPlain{WDN + (size_t)e * DM * 256, 256}); continue; } r -= I_DN;
        transpose_item(a.w_sdn, 256, DM, scr, r, F.lane, RmPlain{WDN + (size_t)64 * DM * 256, 256});
    }
}

__device__ __forceinline__ void p1_phase(Frame& F, const Args& a) {
    const float* mod = (const float*)(a.ws + WS_MOD); bf16_t* H = (bf16_t*)(a.ws + WS_H1);
    const int gw = F.bid * NWAVES + F.wave, NGW = F.G * NWAVES;
    for (int m = gw; m < NTOK; m += NGW) {
        const int b = m >> 11;
        const f32x4* xr = (const f32x4*)(a.x + (size_t)m * DM) + F.lane;
        f32x4 v[4]; float s = 0.f;
#pragma unroll
        for (int j = 0; j < 4; ++j) { v[j] = xr[64 * j]; s += (v[j].x + v[j].y) + (v[j].z + v[j].w); }
        const float mean = wave_sum(s) * (1.f / DM); float s2 = 0.f;
#pragma unroll
        for (int j = 0; j < 4; ++j) { v[j] = v[j] - mean; s2 += (v[j].x * v[j].x + v[j].y * v[j].y) + (v[j].z * v[j].z + v[j].w * v[j].w); }
        const float rstd = 1.f / sqrtf(wave_sum(s2) * (1.f / DM) + LN_EPS);
        u32x2* o8 = (u32x2*)(H + (size_t)m * DM) + F.lane;
#pragma unroll
        for (int j = 0; j < 4; ++j) { const f32x4 sh = *((const f32x4*)(mod + b * 6144) + F.lane + 64 * j), sc = *((const f32x4*)(mod + b * 6144 + DM) + F.lane + 64 * j);
            const f32x4 y = v[j] * rstd * (sc + 1.0f) + sh; u32x2 w; w.x = pk2(y.x, y.y); w.y = pk2(y.z, y.w); o8[64 * j] = w; }
    }
}

__device__ __forceinline__ void glr_tile(Frame& F, const Args& a, int tile) {
    const bf16_t* H = (const bf16_t*)(a.ws + WS_H1); const bf16_t* W = (const bf16_t*)(a.ws + WS_WSM); float* GLR = (float*)(a.ws + WS_GLR);
    const int l15 = F.lane & 15, q = F.lane >> 4;
    const bf16_t* ap = H + (size_t)(tile * 16 + l15) * DM + 8 * q; const bf16_t* bp = W + (size_t)l15 * DM + 8 * q;
    f32x4 acc = {0.f, 0.f, 0.f, 0.f};
#pragma unroll 4
    for (int k = 0; k < DM; k += 32) acc = __builtin_amdgcn_mfma_f32_16x16x32_bf16(*(const bf16x8*)(ap + k), *(const bf16x8*)(bp + k), acc, 0, 0, 0);
#pragma unroll
    for (int r = 0; r < 4; ++r) GLR[(size_t)(tile * 16 + q * 4 + r) * 16 + l15] = acc[r];
}

__device__ __forceinline__ int crow(int r, int hi) { return (r & 3) + 8 * (r >> 2) + 4 * hi; }
constexpr float SB_SKIP = -110.0f;
__device__ __forceinline__ void sb_unit(int bh, int qb, const bf16_t* PROJ, const bf16_t* VT, bf16_t* OSB, int lane) {
    const int b = bh >> 3, h = bh & 7, r32 = lane & 31, hi = lane >> 5, q0 = qb * 32, q = q0 + r32;
    const size_t rowbase = (size_t)b * SEQ;
    bf16x8 qf[4];
    { const bf16_t* qp = PROJ + (rowbase + q) * PW + C_QSB + h * 64 + hi * 8;
#pragma unroll
      for (int s = 0; s < 4; ++s) qf[s] = *(const bf16x8*)(qp + 16 * s); }
    float carry = 0.f;
    f32x16 o0, o1;
#pragma unroll
    for (int r = 0; r < 16; ++r) { o0[r] = 0.f; o1[r] = 0.f; }
    const bf16_t* vt0 = VT + ((size_t)b * 1024 + h * 64 + r32) * SEQ + 4 * hi;
    for (int kb = qb; kb >= 0; --kb) {
        const int k0 = kb * 32;
        const bf16_t* kp = PROJ + (rowbase + k0 + r32) * PW + C_KSB + h * 64 + hi * 8;
        f32x16 p;
#pragma unroll
        for (int r = 0; r < 16; ++r) p[r] = 0.f;
#pragma unroll
        for (int s = 0; s < 4; ++s) p = __builtin_amdgcn_mfma_f32_32x32x16_bf16(*(const bf16x8*)(kp + 16 * s), qf[s], p, 0, 0, 0);
        float lb[16], l1[16];
        const bool diag = (kb == qb);
#pragma unroll
        for (int r = 0; r < 16; ++r) {
            const float z = p[r] * 0.125f;
            const float t = flog(1.0f + fexp(-fabsf(z)));
            lb[r] = fminf(z, 0.f) - t; l1[r] = fminf(-z, 0.f) - t;
            if (diag) { const bool valid = (k0 + crow(r, hi)) < q; if (!valid) { lb[r] = -INFINITY; l1[r] = 0.f; } }
        }
        float G[4], PG[4];
#pragma unroll
        for (int g = 0; g < 4; ++g) { G[g] = (l1[4 * g] + l1[4 * g + 1]) + (l1[4 * g + 2] + l1[4 * g + 3]); PG[g] = __shfl_xor(G[g], 32); }
        float T[4]; T[3] = 0.f;
#pragma unroll
        for (int g = 2; g >= 0; --g) T[g] = T[g + 1] + G[g + 1] + PG[g + 1];
        float w[16];
#pragma unroll
        for (int g = 0; g < 4; ++g) {
            const float base = carry + T[g] + (hi == 0 ? PG[g] : 0.f);
            const float s3 = l1[4 * g + 3], s2 = s3 + l1[4 * g + 2], s1 = s2 + l1[4 * g + 1];
            w[4 * g + 3] = fexp(lb[4 * g + 3] + base);
            w[4 * g + 2] = fexp(lb[4 * g + 2] + base + s3);
            w[4 * g + 1] = fexp(lb[4 * g + 1] + base + s2);
            w[4 * g + 0] = fexp(lb[4 * g + 0] + base + s1);
        }
        carry += (T[0] + G[0] + PG[0]);
#pragma unroll
        for (int s = 0; s < 2; ++s) {
            u32x4 wb; wb.x = pk2(w[8 * s], w[8 * s + 1]); wb.y = pk2(w[8 * s + 2], w[8 * s + 3]); wb.z = pk2(w[8 * s + 4], w[8 * s + 5]); wb.w = pk2(w[8 * s + 6], w[8 * s + 7]);
            const bf16x8 wf = __builtin_bit_cast(bf16x8, wb);
            const bf16_t* vp = vt0 + k0 + 16 * s;
            { const u32x2 a0 = *(const u32x2*)vp, a1 = *(const u32x2*)(vp + 8); u32x4 av; av.x = a0.x; av.y = a0.y; av.z = a1.x; av.w = a1.y;
              o0 = __builtin_amdgcn_mfma_f32_32x32x16_bf16(__builtin_bit_cast(bf16x8, av), wf, o0, 0, 0, 0); }
            { const u32x2 a0 = *(const u32x2*)(vp + 32 * SEQ), a1 = *(const u32x2*)(vp + 32 * SEQ + 8); u32x4 av; av.x = a0.x; av.y = a0.y; av.z = a1.x; av.w = a1.y;
              o1 = __builtin_amdgcn_mfma_f32_32x32x16_bf16(__builtin_bit_cast(bf16x8, av), wf, o1, 0, 0, 0); }
        }
        if (__all(carry < SB_SKIP)) break;
    }
    bf16_t* op = OSB + (rowbase + q) * 512 + h * 64 + 4 * hi;
#pragma unroll
    for (int g = 0; g < 4; ++g) {
        u32x2 w0; w0.x = pk2(o0[4 * g], o0[4 * g + 1]); w0.y = pk2(o0[4 * g + 2], o0[4 * g + 3]); *(u32x2*)(op + 8 * g) = w0;
        u32x2 w1; w1.x = pk2(o1[4 * g], o1[4 * g + 1]); w1.y = pk2(o1[4 * g + 2], o1[4 * g + 3]); *(u32x2*)(op + 32 + 8 * g) = w1;
    }
}

constexpr int GL_GA = 0, GL_GLR = 16384, GL_WUP = 20480, GL_GS = 24576, GL_QS = 26624, GL_KD = 35840, GL_KLT = 45056, GL_PP = 54272, GL_RMS = 63488, GLS = 72;
__device__ __forceinline__ void gla_prep(Frame& F, const Args& a, int bh, int c) {
    const int b = bh >> 2, h = bh & 3, tok0 = b * SEQ + c * 64;
    LAS float* GAm = (LAS float*)(F.lds + GL_GA); LAS float* GLRs = (LAS float*)(F.lds + GL_GLR); LAS float* WUP = (LAS float*)(F.lds + GL_WUP); LAS float* GS = (LAS float*)(F.lds + GL_GS);
    const float* GLR = (const float*)(a.ws + WS_GLR);
    for (int i = F.tid; i < 1024; i += NTHR) { GLRs[i] = GLR[(size_t)tok0 * 16 + i]; WUP[i] = a.w_gup[(i >> 6) * 256 + h * 64 + (i & 63)]; }
    __syncthreads();
    const int d = F.tid & 63, tg = F.tid >> 6;
    float wcol[16];
#pragma unroll
    for (int r = 0; r < 16; ++r) wcol[r] = WUP[r * 64 + d];
    const float bias = a.b_gate[h * 64 + d];
    float loc[8]; float run = 0.f;
#pragma unroll
    for (int i = 0; i < 8; ++i) { const int t = tg * 8 + i; float xv = bias;
#pragma unroll
        for (int r = 0; r < 16; ++r) xv += GLRs[t * 16 + r] * wcol[r];
        run += logsigmoid_(xv) * (1.0f / 16.0f); loc[i] = run; }
    GS[tg * 64 + d] = run;
    __syncthreads();
    float pre = 0.f;
#pragma unroll
    for (int g = 0; g < 8; ++g) pre += (g < tg) ? GS[g * 64 + d] : 0.f;
#pragma unroll
    for (int i = 0; i < 8; ++i) GAm[(tg * 8 + i) * 64 + d] = loc[i] + pre;
    __syncthreads();
}
__device__ __forceinline__ void gla_g1(Frame& F, const Args& a, int unit) {
    const int bh = unit >> 5, c = unit & 31, b = bh >> 2, h = bh & 3, tok0 = b * SEQ + c * 64;
    gla_prep(F, a, bh, c);
    LAS float* GAm = (LAS float*)(F.lds + GL_GA); LAS bf16_t* KLT = (LAS bf16_t*)(F.lds + GL_KLT);
    const bf16_t* PROJ = (const bf16_t*)(a.ws + WS_PROJ); const bf16_t* VTG = (const bf16_t*)(a.ws + WS_VT) + ((size_t)b * 1024 + 512 + h * 128) * SEQ;
    float* KVT = (float*)(a.ws + WS_KVT); float* DEC = (float*)(a.ws + WS_DEC);
    const int d = F.tid & 63, tg = F.tid >> 6;
    const float glast = GAm[63 * 64 + d];
#pragma unroll
    for (int i = 0; i < 8; ++i) { const int t = tg * 8 + i; const float kv = bf2f(PROJ[(size_t)(tok0 + t) * PW + C_KG + h * 64 + d]);
        KLT[d * GLS + t] = (bf16_t)f2bf(kv * fexp(glast - GAm[t * 64 + d])); }
    if (tg == 0) DEC[unit * 64 + d] = fexp(glast);
    __syncthreads();
    const int l15 = F.lane & 15, q = F.lane >> 4;
    const bf16_t* ap = VTG + ((size_t)16 * F.wave + l15) * SEQ + c * 64 + 8 * q;
    const bf16x8 a0 = *(const bf16x8*)ap, a1 = *(const bf16x8*)(ap + 32);
#pragma unroll
    for (int tn = 0; tn < 4; ++tn) {
        const LAS bf16_t* bp = KLT + (16 * tn + l15) * GLS + 8 * q;
        f32x4 acc = {0.f, 0.f, 0.f, 0.f};
        acc = __builtin_amdgcn_mfma_f32_16x16x32_bf16(a0, *(const LAS bf16x8*)bp, acc, 0, 0, 0);
        acc = __builtin_amdgcn_mfma_f32_16x16x32_bf16(a1, *(const LAS bf16x8*)(bp + 32), acc, 0, 0, 0);
#pragma unroll
        for (int r = 0; r < 4; ++r) KVT[((size_t)unit * 128 + 16 * F.wave + q * 4 + r) * 64 + 16 * tn + l15] = acc[r];
    }
    __syncthreads();
}
__device__ __forceinline__ void gla_scan(Frame& F, const Args& a) {
    const float* KVT = (const float*)(a.ws + WS_KVT); const float* DEC = (const float*)(a.ws + WS_DEC); bf16_t* ST = (bf16_t*)(a.ws + WS_ST16);
    for (int e = F.bid * NTHR + F.tid; e < 32 * 8192; e += F.G * NTHR) {
        const int bh = e >> 13, rem = e & 8191, d = rem & 63; float S = 0.f;
        for (int c = 0; c < 32; ++c) { const int unit = bh * 32 + c; const float kv = KVT[(size_t)unit * 8192 + rem];
            ST[(size_t)unit * 8192 + rem] = (bf16_t)f2bf(S); S = DEC[unit * 64 + d] * S + kv; }
    }
}
__device__ __forceinline__ void gla_g3(Frame& F, const Args& a, int unit) {
    const int bh = unit >> 5, c = unit & 31, b = bh >> 2, h = bh & 3, tok0 = b * SEQ + c * 64;
    gla_prep(F, a, bh, c);
    LAS float* GAm = (LAS float*)(F.lds + GL_GA); LAS bf16_t* QS = (LAS bf16_t*)(F.lds + GL_QS); LAS bf16_t* KD = (LAS bf16_t*)(F.lds + GL_KD); LAS bf16_t* PP = (LAS bf16_t*)(F.lds + GL_PP);
    LAS float* RMS = (LAS float*)(F.lds + GL_RMS);
    const bf16_t* PROJ = (const bf16_t*)(a.ws + WS_PROJ); const bf16_t* VTG = (const bf16_t*)(a.ws + WS_VT) + ((size_t)b * 1024 + 512 + h * 128) * SEQ; const bf16_t* ST = (const bf16_t*)(a.ws + WS_ST16);
    bf16_t* OG = (bf16_t*)(a.ws + WS_OG);
    { const int d = F.tid & 63, tg = F.tid >> 6;
#pragma unroll
      for (int i = 0; i < 8; ++i) { const int t = tg * 8 + i; const size_t ro = (size_t)(tok0 + t) * PW + h * 64 + d; const float gv = GAm[t * 64 + d];
          QS[t * GLS + d] = (bf16_t)f2bf(bf2f(PROJ[ro + C_QG]) * 0.125f * fexp(gv)); KD[t * GLS + d] = (bf16_t)f2bf(bf2f(PROJ[ro + C_KG]) * fexp(-gv)); } }
    __syncthreads();
    const int l15 = F.lane & 15, q = F.lane >> 4;
    { const int tm = F.wave >> 1; const LAS bf16_t* ap = QS + (16 * tm + l15) * GLS + 8 * q;
      const bf16x8 a0 = *(const LAS bf16x8*)ap, a1 = *(const LAS bf16x8*)(ap + 32);
#pragma unroll
      for (int j = 0; j < 2; ++j) { const int tn = (F.wave & 1) * 2 + j; const LAS bf16_t* bp = KD + (16 * tn + l15) * GLS + 8 * q;
          f32x4 acc = {0.f, 0.f, 0.f, 0.f};
          acc = __builtin_amdgcn_mfma_f32_16x16x32_bf16(a0, *(const LAS bf16x8*)bp, acc, 0, 0, 0);
          acc = __builtin_amdgcn_mfma_f32_16x16x32_bf16(a1, *(const LAS bf16x8*)(bp + 32), acc, 0, 0, 0);
#pragma unroll
          for (int r = 0; r < 4; ++r) { const int t = 16 * tm + q * 4 + r, s = 16 * tn + l15; PP[t * GLS + s] = (bf16_t)f2bf(s <= t ? acc[r] : 0.f); } } }
    __syncthreads();
    f32x4 acc[4];
    { const bf16_t* vp = VTG + ((size_t)16 * F.wave + l15) * SEQ + c * 64 + 8 * q; const bf16_t* sp = ST + ((size_t)unit * 128 + 16 * F.wave + l15) * 64 + 8 * q;
      const bf16x8 bv0 = *(const bf16x8*)vp, bv1 = *(const bf16x8*)(vp + 32), bs0 = *(const bf16x8*)sp, bs1 = *(const bf16x8*)(sp + 32);
#pragma unroll
      for (int tm = 0; tm < 4; ++tm) { const LAS bf16_t* pp = PP + (16 * tm + l15) * GLS + 8 * q; const LAS bf16_t* qp = QS + (16 * tm + l15) * GLS + 8 * q;
          f32x4 c4 = {0.f, 0.f, 0.f, 0.f};
          c4 = __builtin_amdgcn_mfma_f32_16x16x32_bf16(*(const LAS bf16x8*)pp, bv0, c4, 0, 0, 0);
          c4 = __builtin_amdgcn_mfma_f32_16x16x32_bf16(*(const LAS bf16x8*)(pp + 32), bv1, c4, 0, 0, 0);
          c4 = __builtin_amdgcn_mfma_f32_16x16x32_bf16(*(const LAS bf16x8*)qp, bs0, c4, 0, 0, 0);
          c4 = __builtin_amdgcn_mfma_f32_16x16x32_bf16(*(const LAS bf16x8*)(qp + 32), bs1, c4, 0, 0, 0);
          acc[tm] = c4; } }
#pragma unroll
    for (int tm = 0; tm < 4; ++tm)
#pragma unroll
        for (int r = 0; r < 4; ++r) { float sq = acc[tm][r] * acc[tm][r];
            sq += __shfl_xor(sq, 1); sq += __shfl_xor(sq, 2); sq += __shfl_xor(sq, 4); sq += __shfl_xor(sq, 8);
            if (l15 == 0) RMS[F.wave * 64 + 16 * tm + q * 4 + r] = sq; }
    __syncthreads();
    const int dv = 16 * F.wave + l15; const float nw = a.norm_w[h * 128 + dv];
#pragma unroll
    for (int tm = 0; tm < 4; ++tm)
#pragma unroll
        for (int r = 0; r < 4; ++r) { const int t = 16 * tm + q * 4 + r; float ms = 0.f;
#pragma unroll
            for (int w = 0; w < 8; ++w) ms += RMS[w * 64 + t];
            const float rs = 1.0f / sqrtf(ms * (1.0f / 128.0f) + LN_EPS);
            const float rg = bf2f(PROJ[(size_t)(tok0 + t) * PW + C_RG + h * 128 + dv]);
            OG[(size_t)(tok0 + t) * 512 + h * 128 + dv] = (bf16_t)f2bf(acc[tm][r] * rs * nw * (rg * sigmoidf_(rg))); }
    __syncthreads();
}
constexpr int ATS = 1032;
constexpr int P8_HIST = 64 * ATS * 2;
__device__ __forceinline__ void p8_phase(Frame& F, const Args& a) {
    const float* mod = (const float*)(a.ws + WS_MOD); bf16_t* H2 = (bf16_t*)(a.ws + WS_H2); const bf16_t* WR = (const bf16_t*)(a.ws + WS_WSM + 65536);
    unsigned* gcnt = (unsigned*)(a.ws + WS_CTL) + CW_CNT; int* LIST = (int*)(a.ws + WS_LIST); float* GWT = (float*)(a.ws + WS_GWT); unsigned* SLOT = (unsigned*)(a.ws + WS_SLOT);
    LAS bf16_t* AT = (LAS bf16_t*)F.lds; LAS float* LG = (LAS float*)F.lds; LAS int* HIST = (LAS int*)(F.lds + P8_HIST); LAS int* BASE = HIST + 64;
    for (int blk = F.bid; blk < NTOK / 64; blk += F.G) {
        if (F.tid < 64) HIST[F.tid] = 0;
        for (int i = 0; i < 8; ++i) {
            const int lr = F.wave * 8 + i, m = blk * 64 + lr, b = m >> 11;
            f32x4* pr = (f32x4*)(a.out + (size_t)m * DM) + F.lane;
            f32x4 v[4]; float s = 0.f;
#pragma unroll
            for (int j = 0; j < 4; ++j) { v[j] = pr[64 * j]; s += (v[j].x + v[j].y) + (v[j].z + v[j].w); }
            float mean = wave_sum(s) * (1.f / DM), s2 = 0.f;
#pragma unroll
            for (int j = 0; j < 4; ++j) { v[j] = v[j] - mean; s2 += (v[j].x * v[j].x + v[j].y * v[j].y) + (v[j].z * v[j].z + v[j].w * v[j].w); }
            float rstd = 1.f / sqrtf(wave_sum(s2) * (1.f / DM) + LN_EPS);
            s = 0.f;
#pragma unroll
            for (int j = 0; j < 4; ++j) { const f32x4 g = *((const f32x4*)a.ln1_g + F.lane + 64 * j), be = *((const f32x4*)a.ln1_b + F.lane + 64 * j);
                v[j] = v[j] * rstd * g + be; pr[64 * j] = v[j]; s += (v[j].x + v[j].y) + (v[j].z + v[j].w); }
            mean = wave_sum(s) * (1.f / DM); s2 = 0.f;
#pragma unroll
            for (int j = 0; j < 4; ++j) { v[j] = v[j] - mean; s2 += (v[j].x * v[j].x + v[j].y * v[j].y) + (v[j].z * v[j].z + v[j].w * v[j].w); }
            rstd = 1.f / sqrtf(wave_sum(s2) * (1.f / DM) + LN_EPS);
            u32x2* o8 = (u32x2*)(H2 + (size_t)m * DM) + F.lane; LAS u32x2* l8 = (LAS u32x2*)(AT + lr * ATS) + F.lane;
#pragma unroll
            for (int j = 0; j < 4; ++j) { const f32x4 sh = *((const f32x4*)(mod + b * 6144 + 3 * DM) + F.lane + 64 * j), sc = *((const f32x4*)(mod + b * 6144 + 4 * DM) + F.lane + 64 * j);
                const f32x4 y = v[j] * rstd * (sc + 1.0f) + sh; u32x2 w; w.x = pk2(y.x, y.y); w.y = pk2(y.z, y.w); o8[64 * j] = w; l8[64 * j] = w; }
        }
        __syncthreads();
        const int l15 = F.lane & 15, q = F.lane >> 4, tm = F.wave >> 1;
        f32x4 lg0 = {0.f, 0.f, 0.f, 0.f}, lg1 = {0.f, 0.f, 0.f, 0.f};
        { const LAS bf16_t* ap = AT + (16 * tm + l15) * ATS + 8 * q; const bf16_t* bp0 = WR + (size_t)(16 * ((F.wave & 1) * 2) + l15) * DM + 8 * q; const bf16_t* bp1 = bp0 + 16 * DM;
#pragma unroll 4
          for (int k = 0; k < DM; k += 32) { const bf16x8 av = *(const LAS bf16x8*)(ap + k);
              lg0 = __builtin_amdgcn_mfma_f32_16x16x32_bf16(av, *(const bf16x8*)(bp0 + k), lg0, 0, 0, 0);
              lg1 = __builtin_amdgcn_mfma_f32_16x16x32_bf16(av, *(const bf16x8*)(bp1 + k), lg1, 0, 0, 0); } }
        __syncthreads();
#pragma unroll
        for (int r = 0; r < 4; ++r) { const int row = 16 * tm + q * 4 + r, e0 = 16 * ((F.wave & 1) * 2) + l15; LG[row * 64 + e0] = lg0[r]; LG[row * 64 + e0 + 16] = lg1[r]; }
        __syncthreads();
        const int e = F.lane; const float rb = a.r_bias[e];
        bool sel[8]; int ploc[8], rnk[8]; float wgt[8];
#pragma unroll
        for (int i = 0; i < 8; ++i) {
            const int lr = F.wave * 8 + i;
            const float score = sigmoidf_(LG[lr * 64 + e]); const float sv = score + rb;
            float m1 = sv; m1 = fmaxf(m1, __shfl_xor(m1, 1)); m1 = fmaxf(m1, __shfl_xor(m1, 2)); m1 = fmaxf(m1, __shfl_xor(m1, 4));
            int i1 = (sv == m1) ? e : 64; i1 = min(i1, __shfl_xor(i1, 1)); i1 = min(i1, __shfl_xor(i1, 2)); i1 = min(i1, __shfl_xor(i1, 4));
            float m2 = (e == i1) ? -INFINITY : sv; m2 = fmaxf(m2, __shfl_xor(m2, 1)); m2 = fmaxf(m2, __shfl_xor(m2, 2)); m2 = fmaxf(m2, __shfl_xor(m2, 4));
            const float gs = m1 + m2; const int g = e >> 3;
            int grank = 0;
#pragma unroll
            for (int j = 0; j < 8; ++j) { const float o = __shfl(gs, 8 * j); grank += (o > gs || (o == gs && j < g)) ? 1 : 0; }
            const float sm = (grank < 4) ? sv : -INFINITY;
            int rank = 0;
            for (int j = 0; j < 64; ++j) { const float o = __shfl(sm, j); rank += (o > sm || (o == sm && j < e)) ? 1 : 0; }
            const bool s_ = rank < 8;
            const float wsum = wave_sum(s_ ? score : 0.f);
            sel[i] = s_; rnk[i] = rank; wgt[i] = score / wsum * ROUTED_SCALE;
            ploc[i] = s_ ? __hip_atomic_fetch_add(&HIST[e], 1, __ATOMIC_RELAXED, __HIP_MEMORY_SCOPE_WORKGROUP) : 0;
        }
        __syncthreads();
        if (F.tid < 64) BASE[F.tid] = (int)__hip_atomic_fetch_add(gcnt + F.tid, (unsigned)HIST[F.tid], __ATOMIC_RELAXED, __HIP_MEMORY_SCOPE_AGENT);
        __syncthreads();
        const int base = BASE[e];
#pragma unroll
        for (int i = 0; i < 8; ++i) if (sel[i]) { const int m = blk * 64 + F.wave * 8 + i, p = base + ploc[i];
            LIST[(size_t)e * ECAP + p] = m; GWT[(size_t)e * ECAP + p] = wgt[i]; SLOT[(size_t)m * 8 + rnk[i]] = ((unsigned)e << 16) | (unsigned)p; }
        __syncthreads();
    }
}

constexpr int TB_TE = TAB_OFF, TB_TP = TAB_OFF + 4096, TB_CNT = TAB_OFF + 8192, TB_YOFF = TAB_OFF + 8192 + 512, TB_NT = TAB_OFF + 8192 + 1024;
__device__ __forceinline__ int moe_tables(Frame& F, const Args& a) {
    const unsigned* gcnt = (const unsigned*)(a.ws + WS_CTL) + CW_CNT;
    LAS int* TE = (LAS int*)(F.lds + TB_TE); LAS int* TP = (LAS int*)(F.lds + TB_TP); LAS int* CNT = (LAS int*)(F.lds + TB_CNT); LAS int* YOFF = (LAS int*)(F.lds + TB_YOFF); LAS int* NT = (LAS int*)(F.lds + TB_NT);
    if (F.tid < 64) CNT[F.tid] = (int)__hip_atomic_load(gcnt + F.tid, __ATOMIC_RELAXED, __HIP_MEMORY_SCOPE_AGENT);
    if (F.tid == 64) CNT[64] = NTOK;
    __syncthreads();
    if (F.tid == 0) { int t = 0, y = 0;
        for (int e = 0; e <= NEXP; ++e) { const int c = CNT[e], nt = (c + 255) >> 8; YOFF[e] = y; y += c;
            for (int j = 0; j < nt; ++j) { TE[t] = e; TP[t] = j * 256; ++t; } }
        NT[0] = t; }
    __syncthreads();
    return __builtin_amdgcn_readfirstlane(NT[0]);
}

__device__ __forceinline__ void p11_phase(Frame& F, const Args& a) {
    const float* mod = (const float*)(a.ws + WS_MOD); const bf16_t* YS = (const bf16_t*)(a.ws + WS_YS); const unsigned* SLOT = (const unsigned*)(a.ws + WS_SLOT);
    LAS int* YOFF = (LAS int*)(F.lds + TB_YOFF);
    (void)moe_tables(F, a);
    const int gw = F.bid * NWAVES + F.wave, NGW = F.G * NWAVES;
    for (int m = gw; m < NTOK; m += NGW) {
        const int b = m >> 11;
        f32x4 f[4];
        { const u32x2* yr = (const u32x2*)(YS + (size_t)(NTOK * 8 + m) * DM) + F.lane;
#pragma unroll
          for (int j = 0; j < 4; ++j) { const u32x2 w = yr[64 * j]; f[j] = (f32x4){bflo(w.x), bfhi(w.x), bflo(w.y), bfhi(w.y)}; } }
#pragma unroll
        for (int k = 0; k < 8; ++k) { const unsigned sl = SLOT[(size_t)m * 8 + k]; const int row = YOFF[sl >> 16] + (int)(sl & 0xffffu);
            const u32x2* yr = (const u32x2*)(YS + (size_t)row * DM) + F.lane;
#pragma unroll
            for (int j = 0; j < 4; ++j) { const u32x2 w = yr[64 * j]; f[j] += (f32x4){bflo(w.x), bfhi(w.x), bflo(w.y), bfhi(w.y)}; } }
        f32x4* pr = (f32x4*)(a.out + (size_t)m * DM) + F.lane;
        f32x4 v[4]; float s = 0.f;
#pragma unroll
        for (int j = 0; j < 4; ++j) { const f32x4 g2 = *((const f32x4*)(mod + b * 6144 + 5 * DM) + F.lane + 64 * j);
            v[j] = pr[64 * j] * DN_ALPHA + g2 * f[j]; s += (v[j].x + v[j].y) + (v[j].z + v[j].w); }
        const float mean = wave_sum(s) * (1.f / DM); float s2 = 0.f;
#pragma unroll
        for (int j = 0; j < 4; ++j) { v[j] = v[j] - mean; s2 += (v[j].x * v[j].x + v[j].y * v[j].y) + (v[j].z * v[j].z + v[j].w * v[j].w); }
        const float rstd = 1.f / sqrtf(wave_sum(s2) * (1.f / DM) + LN_EPS);
#pragma unroll
        for (int j = 0; j < 4; ++j) { const f32x4 g = *((const f32x4*)a.ln2_g + F.lane + 64 * j), be = *((const f32x4*)a.ln2_b + F.lane + 64 * j); pr[64 * j] = v[j] * rstd * g + be; }
    }
}

template <int P> __device__ __forceinline__ void run_phase(Frame& F, const Args& a) {
    unsigned char* ws = a.ws;
    if constexpr (P == 0) { p0_phase(F, a); }
    if constexpr (P == 1) { p1_phase(F, a); }
    if constexpr (P == 2) {
        for (int t = F.bid * NWAVES + F.wave; t < NTOK / 16; t += F.G * NWAVES) glr_tile(F, a, t);
        __syncthreads();
        { pg8::Gemm g{(const bf16_t*)(ws + WS_H1), (const bf16_t*)(ws + WS_WIN), NTOK, PW, DM}; pg8::StaticOrder S; S.init(NTOK, PW, F.G, F.bid);
          pg8::EpiStore E{(bf16_t*)(ws + WS_PROJ), PW};
          pg8::gemm_phase<pg8::EpiStore, pg8::StaticOrder, true, pg8::NoGather>(F.lds, g, S, E, pg8::NoGather{}); }
        { pg8::Gemm g{(const bf16_t*)(ws + WS_WV), (const bf16_t*)(ws + WS_H1), 1024, NTOK, DM}; pg8::StaticOrder S; S.init(1024, NTOK, F.G, F.bid);
          pg8::EpiVT E{(bf16_t*)(ws + WS_VT)};
          pg8::gemm_phase<pg8::EpiVT, pg8::StaticOrder, true, pg8::NoGather>(F.lds, g, S, E, pg8::NoGather{}); }
    }
    if constexpr (P == 3) {
        for (int u = F.bid; u < 1024; u += F.G) gla_g1(F, a, u);
        const int gw = F.bid * NWAVES + F.wave, NGW = F.G * NWAVES;
        for (int u = gw; u < 2048; u += NGW) {
            sb_unit(u >> 6, u & 63, (const bf16_t*)(ws + WS_PROJ), (const bf16_t*)(ws + WS_VT), (bf16_t*)(ws + WS_OSB), F.lane);
            const int u2 = 4095 - u;
            sb_unit(u2 >> 6, u2 & 63, (const bf16_t*)(ws + WS_PROJ), (const bf16_t*)(ws + WS_VT), (bf16_t*)(ws + WS_OSB), F.lane);
        }
    }
    if constexpr (P == 4) { gla_scan(F, a); }
    if constexpr (P == 5) { for (int u = F.bid; u < 1024; u += F.G) gla_g3(F, a, u); }
    if constexpr (P == 6) {
        pg8::StaticOrder S; S.init(NTOK, DM, F.G, F.bid);
        { pg8::Gemm g{(const bf16_t*)(ws + WS_OSB), (const bf16_t*)(ws + WS_WSB), NTOK, DM, 512}; pg8::EpiBranch<1> E{(const bf16_t*)(ws + WS_PROJ), (bf16_t*)(ws + WS_Y)};
          pg8::gemm_phase<pg8::EpiBranch<1>, pg8::StaticOrder, true, pg8::NoGather>(F.lds, g, S, E, pg8::NoGather{}); }
        { pg8::Gemm g{(const bf16_t*)(ws + WS_OG), (const bf16_t*)(ws + WS_WGLA), NTOK, DM, 512}; pg8::EpiBranch<2> E{(const bf16_t*)(ws + WS_PROJ), (bf16_t*)(ws + WS_Y)};
          pg8::gemm_phase<pg8::EpiBranch<2>, pg8::StaticOrder, true, pg8::NoGather>(F.lds, g, S, E, pg8::NoGather{}); }
    }
    if constexpr (P == 7) {
        pg8::Gemm g{(const bf16_t*)(ws + WS_Y), (const bf16_t*)(ws + WS_WOUT), NTOK, DM, DM}; pg8::StaticOrder S; S.init(NTOK, DM, F.G, F.bid);
        pg8::EpiOut E{a.x, (const float*)(ws + WS_MOD), a.out};
        pg8::gemm_phase<pg8::EpiOut, pg8::StaticOrder, true, pg8::NoGather>(F.lds, g, S, E, pg8::NoGather{});
    }
    if constexpr (P == 8) { p8_phase(F, a); }
    if constexpr (P == 9) {
        const int ntiles = moe_tables(F, a);
        pg8::MoeTab tb{(const LAS int*)(F.lds + TB_TE), (const LAS int*)(F.lds + TB_TP), (const LAS int*)(F.lds + TB_CNT), (const LAS int*)(F.lds + TB_YOFF)};
        pg8::Gemm g{(const bf16_t*)(ws + WS_H2), (const bf16_t*)(ws + WS_WGU), NTOK, 512, DM};
        pg8::MoeOrder S{ntiles * 2, 2, F.G, F.bid, tb.tile_e};
        pg8::EpiMoe1 E{tb, (const float*)(ws + WS_GWT), (bf16_t*)(ws + WS_ACT)};
        pg8::MoeGather GA{tb, (const int*)(ws + WS_LIST)};
        pg8::gemm_phase<pg8::EpiMoe1, pg8::MoeOrder, true, pg8::MoeGather>(F.lds, g, S, E, GA);
    }
    if constexpr (P == 10) {
        const int ntiles = moe_tables(F, a);
        pg8::MoeTab tb{(const LAS int*)(F.lds + TB_TE), (const LAS int*)(F.lds + TB_TP), (const LAS int*)(F.lds + TB_CNT), (const LAS int*)(F.lds + TB_YOFF)};
        pg8::Gemm g{(const bf16_t*)(ws + WS_ACT), (const bf16_t*)(ws + WS_WDN), NTOK, DM, 256};
        pg8::MoeOrder S{ntiles * 4, 4, F.G, F.bid, tb.tile_e};
        pg8::EpiMoe2 E{tb, (bf16_t*)(ws + WS_YS)};
        pg8::gemm_phase<pg8::EpiMoe2, pg8::MoeOrder, true, pg8::NoGather>(F.lds, g, S, E, pg8::NoGather{});
    }
    if constexpr (P == 11) { p11_phase(F, a); }
}
#define MK_FRAME() extern __shared__ __attribute__((aligned(16))) unsigned char lds_raw[]; \
    Frame F; F.lds = (LAS unsigned char*)lds_raw; F.tid = threadIdx.x; F.lane = F.tid & 63; F.wave = __builtin_amdgcn_readfirstlane(F.tid >> 6); F.G = gridDim.x; F.bid = blockIdx.x;

template <int P> __global__ void __launch_bounds__(NTHR, 2) fwd_ph(Args a) { MK_FRAME(); run_phase<P>(F, a); }

#ifndef N_LAUNCHES
#define N_LAUNCHES 12
#endif
#if N_LAUNCHES == 1
__global__ void __launch_bounds__(NTHR, 2) fwd_all(Args a) {
    MK_FRAME();
    cg::grid_group grid = cg::this_grid();
    run_phase<0>(F, a); grid.sync();
    run_phase<1>(F, a); grid.sync();
    run_phase<2>(F, a); grid.sync();
    run_phase<3>(F, a); grid.sync();
    run_phase<4>(F, a); grid.sync();
    run_phase<5>(F, a); grid.sync();
    run_phase<6>(F, a); grid.sync();
    run_phase<7>(F, a); grid.sync();
    run_phase<8>(F, a); grid.sync();
    run_phase<9>(F, a); grid.sync();
    run_phase<10>(F, a); grid.sync();
    run_phase<11>(F, a);
}
#endif

template <int P> static void launch_ph(int grid, const Args& a, hipStream_t stream) {
    static bool attr = false;
    if (!attr) { (void)hipFuncSetAttribute((const void*)fwd_ph<P>, hipFuncAttributeMaxDynamicSharedMemorySize, LDS_BYTES); attr = true; }
    hipLaunchKernelGGL(fwd_ph<P>, dim3(grid), dim3(NTHR), LDS_BYTES, stream, a);
}
extern "C" void kernel_launch(void* const* d_in, const int* in_sizes, int n_in, void* d_out, int out_size, void* d_ws, size_t ws_size, hipStream_t stream) {
    static int grid = 0;
    if (grid == 0) {
        if (n_in != 21 || out_size != NTOK * DM || ws_size < WS_END) { fprintf(stderr, "kernel_launch: unexpected shapes (n_in %d out %d ws %zu)\n", n_in, out_size, ws_size); grid = -1; return; }
        int dev = 0, cus = 0, per_cu = 0;
        (void)hipGetDevice(&dev); (void)hipDeviceGetAttribute(&cus, hipDeviceAttributeMultiprocessorCount, dev);
#if N_LAUNCHES == 1
        if (hipFuncSetAttribute((const void*)fwd_all, hipFuncAttributeMaxDynamicSharedMemorySize, LDS_BYTES) != hipSuccess) { fprintf(stderr, "kernel_launch: hipFuncSetAttribute failed\n"); grid = -1; return; }
        (void)hipOccupancyMaxActiveBlocksPerMultiprocessor(&per_cu, (const void*)fwd_all, NTHR, LDS_BYTES);
#else
        per_cu = 1;
#endif
        (void)hipGetLastError();
        if (per_cu < 1) { fprintf(stderr, "kernel_launch: occupancy query reports %d blocks per CU\n", per_cu); per_cu = 1; }
        grid = cus;
        fprintf(stderr, "kernel_launch: cus %d per_cu %d grid %d\n", cus, per_cu, grid);
    }
    if (grid < 0) return;
    (void)hipMemsetAsync((char*)d_ws + WS_CTL, 0, CTL_ZERO_BYTES, stream);
    Args a{};
    const float** ap = (const float**)&a;
    for (int i = 0; i < 21; ++i) ap[i] = (const float*)d_in[i];
    a.out = (float*)d_out; a.ws = (unsigned char*)d_ws;
#if N_LAUNCHES == 1
    {
        void* args[] = {&a};
        hipError_t e = hipLaunchCooperativeKernel((const void*)fwd_all, dim3(grid), dim3(NTHR), args, LDS_BYTES, stream);
        if (e != hipSuccess) fprintf(stderr, "kernel_launch: cooperative launch failed: %s\n", hipGetErrorString(e));
    }
#else
    {
        launch_ph<0>(grid, a, stream); launch_ph<1>(grid, a, stream); launch_ph<2>(grid, a, stream); launch_ph<3>(grid, a, stream);
        launch_ph<4>(grid, a, stream); launch_ph<5>(grid, a, stream); launch_ph<6>(grid, a, stream); launch_ph<7>(grid, a, stream);
        launch_ph<8>(grid, a, stream); launch_ph<9>(grid, a, stream); launch_ph<10>(grid, a, stream); launch_ph<11>(grid, a, stream);
    }
#endif
}
```

```cpp
#include <hip/hip_runtime.h>
#include <hip/hip_cooperative_groups.h>
#include <cstdio>
#include <cstdint>
namespace cg = cooperative_groups;

#define LAS __attribute__((address_space(3)))
#define GAS __attribute__((address_space(1)))
typedef unsigned short bf16_t;
typedef short bf16x8 __attribute__((ext_vector_type(8)));
typedef short bf16x4 __attribute__((ext_vector_type(4)));
typedef float f32x4 __attribute__((ext_vector_type(4)));
typedef float f32x16 __attribute__((ext_vector_type(16)));
typedef unsigned u32x4 __attribute__((ext_vector_type(4)));
typedef unsigned u32x2 __attribute__((ext_vector_type(2)));
typedef int i32x8 __attribute__((ext_vector_type(8))); typedef int i32x4 __attribute__((ext_vector_type(4)));

#define LDS_WAIT() asm volatile("s_waitcnt lgkmcnt(0)" ::: "memory")
#define VM_WAIT() asm volatile("s_waitcnt vmcnt(0)" ::: "memory")

__device__ __forceinline__ unsigned f2bf(float f) { unsigned u = __builtin_bit_cast(unsigned, f); return (u + 0x7fffu + ((u >> 16) & 1u)) >> 16; }
typedef float f32x2_t __attribute__((ext_vector_type(2))); typedef __bf16 bf16x2_t __attribute__((ext_vector_type(2)));
__device__ __forceinline__ unsigned pk2(float lo, float hi) { f32x2_t v = {lo, hi}; bf16x2_t b = __builtin_convertvector(v, bf16x2_t); return __builtin_bit_cast(unsigned, b); }
__device__ __forceinline__ float bf2f(unsigned short b) { return __builtin_bit_cast(float, (unsigned)b << 16); }
__device__ __forceinline__ float bflo(unsigned w) { return __builtin_bit_cast(float, w << 16); }
__device__ __forceinline__ float bfhi(unsigned w) { return __builtin_bit_cast(float, w & 0xffff0000u); }
__device__ __forceinline__ float fexp(float x) { return __builtin_amdgcn_exp2f(x * 1.4426950408889634f); }
__device__ __forceinline__ float flog(float x) { return __builtin_amdgcn_logf(x) * 0.6931471805599453f; }
__device__ __forceinline__ float sigmoidf_(float x) { return __builtin_amdgcn_rcpf(1.0f + fexp(-x)); }
__device__ __forceinline__ float logsigmoid_(float x) { return fminf(x, 0.f) - flog(1.0f + fexp(-fabsf(x))); }
template <int CTRL> __device__ __forceinline__ float dppf(float v) { return __builtin_bit_cast(float, __builtin_amdgcn_update_dpp(0, __builtin_bit_cast(int, v), CTRL, 0xF, 0xF, true)); }
template <int CTRL> __device__ __forceinline__ int dppi(int v) { return __builtin_amdgcn_update_dpp(0, v, CTRL, 0xF, 0xF, true); }
template <int L> __device__ __forceinline__ float rlane(float v) { return __builtin_bit_cast(float, __builtin_amdgcn_readlane(__builtin_bit_cast(int, v), L)); }
__device__ __forceinline__ float row16_sum(float v) { v += dppf<0xB1>(v); v += dppf<0x4E>(v); v += dppf<0x141>(v); v += dppf<0x140>(v); return v; }
__device__ __forceinline__ float grp8_max(float v) { v = fmaxf(v, dppf<0xB1>(v)); v = fmaxf(v, dppf<0x4E>(v)); v = fmaxf(v, dppf<0x141>(v)); return v; }
__device__ __forceinline__ int grp8_min(int v) { v = min(v, dppi<0xB1>(v)); v = min(v, dppi<0x4E>(v)); v = min(v, dppi<0x141>(v)); return v; }
__device__ __forceinline__ float wave_max(float v) {
    v = fmaxf(v, dppf<0xB1>(v)); v = fmaxf(v, dppf<0x4E>(v)); v = fmaxf(v, dppf<0x141>(v)); v = fmaxf(v, dppf<0x140>(v));
    return fmaxf(fmaxf(rlane<0>(v), rlane<16>(v)), fmaxf(rlane<32>(v), rlane<48>(v)));
}
__device__ __forceinline__ float wave_sum(float v) {
    v = row16_sum(v);
    return (rlane<0>(v) + rlane<16>(v)) + (rlane<32>(v) + rlane<48>(v));
}

constexpr int NTOK = 16384, DM = 1024, SEQ = 2048, NB = 8;
constexpr int PW = 4096;
constexpr int C_QSB = 0, C_KSB = 512, C_QG = 1024, C_KG = 1280, C_RG = 1536, C_MG = 2048;
constexpr int NEXP = 64, ECAP = 16384;
constexpr float LN_EPS = 1e-5f;
constexpr float DN_ALPHA = 1.189207115002721f;
constexpr float ROUTED_SCALE = 2.5f;

constexpr size_t MiB = 1u << 20;
constexpr size_t WS_CTL = 0, CTL_ZERO_BYTES = 1 * MiB;
constexpr size_t WS_MOD = 1 * MiB;
constexpr size_t WS_GLR = 2 * MiB;
constexpr size_t WS_DEC = 3 * MiB;
constexpr size_t WS_SLOT = 4 * MiB;
constexpr size_t WS_LIST = 6 * MiB;
constexpr size_t WS_GWT = 10 * MiB;
constexpr size_t WS_WSM = 14 * MiB;
constexpr size_t WS_WCAT = 15 * MiB, WS_WOUT = 17 * MiB;
constexpr size_t WS_WIN = 19 * MiB;
constexpr size_t WS_WV = 27 * MiB;
constexpr size_t WS_WDN = 29 * MiB;
constexpr size_t WS_WGU = 62 * MiB;
constexpr size_t WS_H1 = 127 * MiB;
constexpr size_t WS_PROJ = 159 * MiB;
constexpr size_t WS_VT = 319 * MiB;
constexpr size_t WS_OCAT = 351 * MiB;
constexpr size_t WS_Y = 383 * MiB;
constexpr size_t WS_KVT = 415 * MiB;
constexpr size_t WS_ST16 = 447 * MiB;
constexpr size_t WS_H2 = 463 * MiB;
constexpr size_t WS_ACT = 127 * MiB;
constexpr size_t WS_YS = 207 * MiB;
constexpr size_t WS_END = 495 * MiB;
constexpr int CW_BAR = 4096;
constexpr int CW_CNT = 8192;

namespace pg8 {
constexpr int BM = 256, BK = 64, HALF = 128, HTB = HALF * BK * 2, STAGE_BYTES = 8 * HTB, NXCD = 8, WGM = 8;
__host__ __device__ __forceinline__ int lds_byte(int r, int c) { const int st = (r >> 4) * 2 + (c >> 5), rr = r & 15, cc = c & 31, ob = rr * 64 + cc * 2; return st * 1024 + (ob ^ (((ob >> 9) & 1) << 5)); }
__host__ __device__ __forceinline__ void stage_rc(int b, int& R, int& C) { const int st = b / 1024, sb = b % 1024, swz = sb ^ (((sb >> 9) & 1) << 5); R = (st >> 1) * 16 + swz / 64; C = (st & 1) * 32 + (swz % 64) / 2; }
__host__ __device__ __forceinline__ int perm32(int rho) { const int n = rho >> 4, i = rho & 15; return 8 * (i >> 2) + 4 * n + (i & 3); }

struct Unit { int pm, pn; };
struct Gemm { const bf16_t* A; const bf16_t* Bt; int M, N, K; };

struct StaticOrder {
    int nM, nN, nwg, G, c;
    __host__ __device__ void init(int M, int N, int G_, int c_) { nM = M / BM; nN = N / BM; nwg = nM * nN; G = G_; c = c_; }
    __host__ __device__ bool next(int i, Unit& u) const {
        const long L = (long)i * G + c; if (L >= nwg) return false;
        int wgid = (int)L; { const int q = nwg / NXCD, r = nwg % NXCD, xcd = wgid % NXCD, off = wgid / NXCD; wgid = (xcd < r ? xcd * (q + 1) : r * (q + 1) + (xcd - r) * q) + off; }
        const int nig = WGM * nN, gid = wgid / nig, fm = gid * WGM, gsz = (nM - fm) < WGM ? (nM - fm) : WGM;
        u.pm = fm + ((wgid % nig) % gsz); u.pn = (wgid % nig) / gsz; return true;
    }
};
struct MoeOrder {
    int nunits, nN, G, c; const LAS int* tile_e;
    __device__ __forceinline__ bool next(int i, Unit& u) const {
        const int v = ((G & 7) == 0) ? (c & 7) * (G >> 3) + (c >> 3) : c;
        const long L = (long)i * G + v; if (L >= nunits) return false;
        const int tile = (int)L / nN, pnl = (int)L % nN;
        const int e = __builtin_amdgcn_readfirstlane(tile_e[tile]);
        u.pm = tile; u.pn = e * nN + pnl; return true;
    }
};
struct NoGather { static constexpr bool ON = false; __device__ __forceinline__ unsigned row(const Unit&, int) const { return 0u; } };

template <class Epi, class Sched, bool ALIGN_EPI, class Gath, bool F8 = false>
__device__ __forceinline__ void gemm_phase(LAS unsigned char* lds, const Gemm g, const Sched& S, const Epi& E, const Gath& GA) {
    int tid_ = threadIdx.x; asm volatile("" : "+v"(tid_));
    const int tid = tid_, wid = __builtin_amdgcn_readfirstlane(tid >> 6), lane = tid & 63, wr = wid >> 2, wc = wid & 3, fr = lane & 15, fq = lane >> 4;
    const int K = g.K, nt = K / BK;
    unsigned voffA[2], voffB[2]; int RA[2], CA2[2];
#pragma unroll
    for (int i = 0; i < 2; ++i) { int R, C; stage_rc(tid * 16 + i * 8192, R, C); const int Rb = Epi::PERM ? ((R & ~31) + perm32(R & 31)) : R;
        voffA[i] = (unsigned)(R * K + C) * 2u; voffB[i] = (unsigned)(Rb * K + C) * 2u; RA[i] = R; CA2[i] = C * 2; }
    const size_t kstep = (size_t)(BK * 2);
    const size_t hstep = (size_t)HALF * K * 2;
    const size_t tstep = 2 * hstep;
    const size_t hstepA = Gath::ON ? 0 : hstep;
    const unsigned ldsw = (unsigned)wid * 1024u;
    const int aoff = lds_byte(wr * 64 + fr, fq * 8), boff = lds_byte(wc * 32 + fr, fq * 8);
#define PG8_SA(b, h) (((b) * 2 + (h)) * HTB)
#define PG8_SB(b, h) ((4 + (b) * 2 + (h)) * HTB)
#define PG8_STAGE(bufoff, gbase, voff) do { _Pragma("unroll") for (int _i = 0; _i < 2; ++_i) \
        __builtin_amdgcn_global_load_lds((const unsigned*)((const char*)(gbase) + (voff)[_i]), (LAS unsigned*)(lds + (bufoff) + ldsw + _i * 8192), 16, 0, 0); } while (0)
#define PG8_STAGE_A(bufoff, gbase, h, usenext) do { if constexpr (Gath::ON) { unsigned _o[2]; _o[0] = (usenext) ? gan[h][0] : gac[h][0]; _o[1] = (usenext) ? gan[h][1] : gac[h][1]; PG8_STAGE(bufoff, gbase, _o); } \
        else { PG8_STAGE(bufoff, (gbase) + (h) * hstepA, voffA); } } while (0)
#define PG8_LDA(dst, b, h) do { _Pragma("unroll") for (int m = 0; m < 4; ++m) _Pragma("unroll") for (int k = 0; k < 2; ++k) dst[m].q[k] = *(const LAS bf16x8*)(lds + PG8_SA(b, h) + aoff + m * 2048 + k * 1024); } while (0)
#define PG8_LDB(dst, b, h) do { _Pragma("unroll") for (int n = 0; n < 2; ++n) _Pragma("unroll") for (int k = 0; k < 2; ++k) dst[n].q[k] = *(const LAS bf16x8*)(lds + PG8_SB(b, h) + boff + n * 2048 + k * 1024); } while (0)
#define PG8_MMA(ai, bj, At, Bt) do { __builtin_amdgcn_s_setprio(1); \
        if constexpr (F8) { _Pragma("unroll") for (int m = 0; m < 4; ++m) _Pragma("unroll") for (int n = 0; n < 2; ++n) \
            asm volatile("v_mfma_f32_16x16x128_f8f6f4 %0, %1, %2, %0" : "+v"(acc[ai][bj][m][n]) : "v"(Bt[n].w), "v"(At[m].w)); } \
        else { _Pragma("unroll") for (int m = 0; m < 4; ++m) _Pragma("unroll") for (int n = 0; n < 2; ++n) _Pragma("unroll") for (int k = 0; k < 2; ++k) \
            acc[ai][bj][m][n] = __builtin_amdgcn_mfma_f32_16x16x32_bf16(Bt[n].q[k], At[m].q[k], acc[ai][bj][m][n], 0, 0, 0); } \
        __builtin_amdgcn_s_setprio(0); } while (0)
#define PG8_WAIT_V(n) asm volatile("s_waitcnt vmcnt(" #n ")" ::: "memory")
#define PG8_WAIT_L(n) asm volatile("s_waitcnt lgkmcnt(" #n ")" ::: "memory")
#define PG8_BAR __builtin_amdgcn_s_barrier()
#define PG8_SCHED __builtin_amdgcn_sched_barrier(0)
    Unit cur, nxt; int ui = 0;
    if (!S.next(0, cur)) return;
    f32x4 acc[2][2][4][2];
#pragma unroll
    for (int a = 0; a < 2; ++a)
#pragma unroll
        for (int b = 0; b < 2; ++b)
#pragma unroll
            for (int m = 0; m < 4; ++m)
#pragma unroll
                for (int n = 0; n < 2; ++n) acc[a][b][m][n] = (f32x4){0.f, 0.f, 0.f, 0.f};
    union Frag { bf16x8 q[2]; i32x8 w; }; Frag At[4], B0[2], B1[2];
    unsigned gac[2][2], gan[2][2];
    if constexpr (Gath::ON) {
#pragma unroll
        for (int h = 0; h < 2; ++h)
#pragma unroll
            for (int i = 0; i < 2; ++i) { gac[h][i] = GA.row(cur, h * HALF + RA[i]) * (unsigned)(K * 2) + (unsigned)CA2[i]; gan[h][i] = gac[h][i]; }
    }
    const char* cA = (const char*)g.A + (Gath::ON ? (size_t)0 : (size_t)cur.pm * tstep); const char* cB = (const char*)g.Bt + (size_t)cur.pn * tstep;
    PG8_STAGE(PG8_SB(0, 0), cB, voffB); PG8_STAGE(PG8_SB(0, 1), cB + hstep, voffB); PG8_STAGE_A(PG8_SA(0, 0), cA, 0, false); PG8_STAGE_A(PG8_SA(0, 1), cA, 1, false);
    if (wr == 1) PG8_BAR;
    PG8_WAIT_V(2); PG8_BAR;
    PG8_STAGE(PG8_SB(1, 0), cB + kstep, voffB); PG8_STAGE_A(PG8_SA(1, 0), cA + kstep, 0, false); PG8_STAGE(PG8_SB(1, 1), cB + hstep + kstep, voffB);
    PG8_WAIT_V(6); PG8_BAR;
    for (;;) {
        const bool has_next = S.next(ui + 1, nxt);
        const char* nA = (has_next && !Gath::ON) ? (const char*)g.A + (size_t)nxt.pm * tstep : cA; const char* nB = has_next ? (const char*)g.Bt + (size_t)nxt.pn * tstep : cB;
        if constexpr (Gath::ON) {
            if (has_next) {
#pragma unroll
                for (int h = 0; h < 2; ++h)
#pragma unroll
                    for (int i = 0; i < 2; ++i) gan[h][i] = GA.row(nxt, h * HALF + RA[i]) * (unsigned)(K * 2) + (unsigned)CA2[i];
            }
        }
#pragma unroll 1
        for (int t = 0; t < nt; t += 2) {
            const bool last = (t == nt - 2);
            if constexpr (Epi::MIDK) { if (t == nt / 2) E.mid(acc, cur, wr, wc, fr, fq); }
            const char* a1 = cA + (size_t)(t + 1) * kstep;
            const char* a2 = last ? nA : cA + (size_t)(t + 2) * kstep; const char* b2 = last ? nB : cB + (size_t)(t + 2) * kstep;
            const char* a3 = a2 + kstep; const char* b3 = b2 + kstep;
            PG8_LDB(B0, 0, 0); PG8_LDB(B1, 0, 1); PG8_SCHED; PG8_LDA(At, 0, 0); PG8_STAGE_A(PG8_SA(1, 1), a1, 1, false);
            PG8_WAIT_V(8); PG8_WAIT_L(0); PG8_BAR; PG8_MMA(0, 0, At, B0); PG8_MMA(0, 1, At, B1); PG8_BAR; PG8_SCHED;
            PG8_LDA(At, 0, 1); PG8_STAGE(PG8_SB(0, 0), b2, voffB); PG8_STAGE(PG8_SB(0, 1), b2 + hstep, voffB); PG8_STAGE_A(PG8_SA(0, 0), a2, 0, last);
            PG8_WAIT_V(8); PG8_WAIT_L(0); PG8_BAR; PG8_MMA(1, 0, At, B0); PG8_MMA(1, 1, At, B1); PG8_BAR; PG8_SCHED;
            PG8_LDB(B0, 1, 0); PG8_LDB(B1, 1, 1); PG8_SCHED; PG8_LDA(At, 1, 0); PG8_STAGE_A(PG8_SA(0, 1), a2, 1, last);
            PG8_WAIT_V(8); PG8_WAIT_L(0); PG8_BAR; PG8_MMA(0, 0, At, B0); PG8_MMA(0, 1, At, B1); PG8_BAR; PG8_SCHED;
            PG8_LDA(At, 1, 1); PG8_STAGE(PG8_SB(1, 0), b3, voffB); PG8_STAGE(PG8_SB(1, 1), b3 + hstep, voffB); PG8_STAGE_A(PG8_SA(1, 0), a3, 0, last);
            PG8_WAIT_V(8); PG8_WAIT_L(0); PG8_BAR; PG8_MMA(1, 0, At, B0); PG8_MMA(1, 1, At, B1); PG8_BAR; PG8_SCHED;
        }
        if constexpr (F8) { PG8_SCHED; asm volatile("s_nop 15\n\ts_nop 15" ::: "memory"); PG8_SCHED; }
        if constexpr (ALIGN_EPI) { if (wr == 0) PG8_BAR; }
        E(acc, cur, wr, wc, fr, fq);
        if (!has_next) break;
#pragma unroll
        for (int a = 0; a < 2; ++a)
#pragma unroll
            for (int b = 0; b < 2; ++b)
#pragma unroll
                for (int m = 0; m < 4; ++m)
#pragma unroll
                    for (int n = 0; n < 2; ++n) acc[a][b][m][n] = (f32x4){0.f, 0.f, 0.f, 0.f};
        cur = nxt; cA = nA; cB = nB; ++ui;
        if constexpr (Gath::ON) {
#pragma unroll
            for (int h = 0; h < 2; ++h)
#pragma unroll
                for (int i = 0; i < 2; ++i) gac[h][i] = gan[h][i];
        }
        if constexpr (ALIGN_EPI) { if (wr == 1) PG8_BAR; }
    }
    PG8_WAIT_V(0);
    if constexpr (!ALIGN_EPI) { if (wr == 0) PG8_BAR; }
    PG8_BAR;
#undef PG8_SA
#undef PG8_SB
#undef PG8_STAGE
#undef PG8_STAGE_A
#undef PG8_LDA
#undef PG8_LDB
#undef PG8_MMA
#undef PG8_WAIT_V
#undef PG8_WAIT_L
#undef PG8_BAR
#undef PG8_SCHED
}
}
constexpr float F8W_SCALE = 256.f, F8H_SCALE = 8.f, F8A_SCALE = 8.f;
__device__ __forceinline__ unsigned pack4_e4m3(float x0, float x1, float x2, float x3, float sc) {
    const float c0 = __builtin_amdgcn_fmed3f(x0 * sc, -440.f, 440.f), c1 = __builtin_amdgcn_fmed3f(x1 * sc, -440.f, 440.f), c2 = __builtin_amdgcn_fmed3f(x2 * sc, -440.f, 440.f), c3 = __builtin_amdgcn_fmed3f(x3 * sc, -440.f, 440.f);
    int r = __builtin_amdgcn_cvt_pk_fp8_f32(c0, c1, 0, false); r = __builtin_amdgcn_cvt_pk_fp8_f32(c2, c3, r, true); return (unsigned)r; }
namespace pg8 {
typedef const f32x4 (&AccRef)[2][2][4][2];

struct EpiStore {
    static constexpr bool PERM = true; static constexpr bool MIDK = false;
    bf16_t* o; int ldc;
    __device__ __forceinline__ void operator()(AccRef acc, const Unit& u, int wr, int wc, int fr, int fq) const {
        const int row0 = u.pm * BM + wr * 64 + fr, col0 = u.pn * BM + wc * 32 + 8 * fq;
#pragma unroll
        for (int ai = 0; ai < 2; ++ai)
#pragma unroll
            for (int m = 0; m < 4; ++m) { bf16_t* rowp = o + (unsigned)((row0 + ai * HALF + m * 16) * ldc + col0);
#pragma unroll
                for (int bj = 0; bj < 2; ++bj) { const f32x4 v0 = acc[ai][bj][m][0], v1 = acc[ai][bj][m][1];
                    u32x4 w; w.x = pk2(v0[0], v0[1]); w.y = pk2(v0[2], v0[3]); w.z = pk2(v1[0], v1[1]); w.w = pk2(v1[2], v1[3]);
                    *(u32x4*)(rowp + bj * HALF) = w; } }
    }
};
struct EpiVT {
    static constexpr bool PERM = true; static constexpr bool MIDK = false;
    bf16_t* vt;
    __device__ __forceinline__ void operator()(AccRef acc, const Unit& u, int wr, int wc, int fr, int fq) const {
        const int row0 = u.pm * BM + wr * 64 + fr, b = u.pn >> 3, t0 = (u.pn & 7) * BM + wc * 32 + 8 * fq;
#pragma unroll
        for (int ai = 0; ai < 2; ++ai)
#pragma unroll
            for (int m = 0; m < 4; ++m) { bf16_t* rowp = vt + (unsigned)((b * 1024 + row0 + ai * HALF + m * 16) * SEQ + t0);
#pragma unroll
                for (int bj = 0; bj < 2; ++bj) { const f32x4 v0 = acc[ai][bj][m][0], v1 = acc[ai][bj][m][1];
                    u32x4 w; w.x = pk2(v0[0], v0[1]); w.y = pk2(v0[2], v0[3]); w.z = pk2(v1[0], v1[1]); w.w = pk2(v1[2], v1[3]);
                    *(u32x4*)(rowp + bj * HALF) = w; } }
    }
};

typedef f32x4 (&AccRefW)[2][2][4][2];
struct EpiBranch {
    static constexpr bool PERM = true; static constexpr bool MIDK = true;
    const bf16_t* proj; bf16_t* y;
    __device__ __forceinline__ void mid(AccRefW acc, const Unit& u, int wr, int wc, int fr, int fq) const {
        const int row0 = u.pm * BM + wr * 64 + fr, col0 = u.pn * BM + wc * 32 + 8 * fq;
#pragma unroll
        for (int ai = 0; ai < 2; ++ai)
#pragma unroll
            for (int m = 0; m < 4; ++m) { const unsigned ro = (unsigned)((row0 + ai * HALF + m * 16) * PW + C_MG + col0);
#pragma unroll
                for (int bj = 0; bj < 2; ++bj) {
                    const u32x4 ms = *(const u32x4*)(proj + ro + bj * HALF), mg = *(const u32x4*)(proj + ro + 1024 + bj * HALF);
                    const unsigned msw[4] = {ms.x, ms.y, ms.z, ms.w}, mgw[4] = {mg.x, mg.y, mg.z, mg.w};
#pragma unroll
                    for (int k = 0; k < 4; ++k) {
                        const float r0 = (1.0f + fexp(fminf(-bflo(mgw[k]), 80.f))) * __builtin_amdgcn_rcpf(1.0f + fexp(fminf(-bflo(msw[k]), 80.f)));
                        const float r1 = (1.0f + fexp(fminf(-bfhi(mgw[k]), 80.f))) * __builtin_amdgcn_rcpf(1.0f + fexp(fminf(-bfhi(msw[k]), 80.f)));
                        acc[ai][bj][m][k >> 1][(k & 1) * 2] *= r0; acc[ai][bj][m][k >> 1][(k & 1) * 2 + 1] *= r1; } } }
    }
    __device__ __forceinline__ void operator()(AccRef acc, const Unit& u, int wr, int wc, int fr, int fq) const {
        const int row0 = u.pm * BM + wr * 64 + fr, col0 = u.pn * BM + wc * 32 + 8 * fq;
#pragma unroll
        for (int ai = 0; ai < 2; ++ai)
#pragma unroll
            for (int m = 0; m < 4; ++m) { const unsigned row = (unsigned)(row0 + ai * HALF + m * 16);
#pragma unroll
                for (int bj = 0; bj < 2; ++bj) {
                    const int col = col0 + bj * HALF;
                    const u32x4 g = *(const u32x4*)(proj + row * PW + C_MG + 1024 + col);
                    const f32x4 v0 = acc[ai][bj][m][0], v1 = acc[ai][bj][m][1];
                    float o[8];
                    o[0] = sigmoidf_(bflo(g.x)) * v0[0]; o[1] = sigmoidf_(bfhi(g.x)) * v0[1]; o[2] = sigmoidf_(bflo(g.y)) * v0[2]; o[3] = sigmoidf_(bfhi(g.y)) * v0[3];
                    o[4] = sigmoidf_(bflo(g.z)) * v1[0]; o[5] = sigmoidf_(bfhi(g.z)) * v1[1]; o[6] = sigmoidf_(bflo(g.w)) * v1[2]; o[7] = sigmoidf_(bfhi(g.w)) * v1[3];
                    u32x4 w; w.x = pk2(o[0], o[1]); w.y = pk2(o[2], o[3]); w.z = pk2(o[4], o[5]); w.w = pk2(o[6], o[7]);
                    *(u32x4*)(y + row * DM + col) = w; } }
    }
};

struct EpiOut {
    static constexpr bool PERM = true; static constexpr bool MIDK = false;
    const float* mod; bf16_t* g1m;
    __device__ __forceinline__ void operator()(AccRef acc, const Unit& u, int wr, int wc, int fr, int fq) const {
        const int row0 = u.pm * BM + wr * 64 + fr, col0 = u.pn * BM + wc * 32 + 8 * fq;
        const int b = (u.pm * BM) >> 11;
        f32x4 gv[2][2];
#pragma unroll
        for (int bj = 0; bj < 2; ++bj)
#pragma unroll
            for (int n = 0; n < 2; ++n) gv[bj][n] = *(const f32x4*)(mod + b * 6144 + 2 * DM + col0 + bj * HALF + 4 * n);
#pragma unroll
        for (int ai = 0; ai < 2; ++ai)
#pragma unroll
            for (int m = 0; m < 4; ++m) { bf16_t* rowp = g1m + (unsigned)((row0 + ai * HALF + m * 16) * (2 * DM) + col0);
#pragma unroll
                for (int bj = 0; bj < 2; ++bj) { const f32x4 v0 = acc[ai][bj][m][0] * gv[bj][0], v1 = acc[ai][bj][m][1] * gv[bj][1];
                    u32x4 w; w.x = pk2(v0[0], v0[1]); w.y = pk2(v0[2], v0[3]); w.z = pk2(v1[0], v1[1]); w.w = pk2(v1[2], v1[3]);
                    *(u32x4*)(rowp + bj * HALF) = w; } }
    }
};

struct MoeTab { const LAS int* tile_e; const LAS int* tile_p0; const LAS int* cnt; const LAS int* yoff; };

struct MoeGather {
    static constexpr bool ON = true;
    MoeTab tb; const int* list;
    __device__ __forceinline__ unsigned row(const Unit& u, int r) const {
        const int e = tb.tile_e[u.pm], p = tb.tile_p0[u.pm] + r;
        if (e == NEXP) return (unsigned)p;
        return (p < tb.cnt[e]) ? (unsigned)list[(unsigned)(e * ECAP + p)] : 0u;
    }
};

struct EpiMoe1 {
    static constexpr bool PERM = true; static constexpr bool MIDK = false;
    unsigned char* act; float s;
    __device__ __forceinline__ void operator()(AccRef acc, const Unit& u, int wr, int wc, int fr, int fq) const {
        const int pnl = u.pn & 1;
        const int r0 = wr * 64 + fr, colo = pnl * 128 + wc * 32 + 8 * fq;
#pragma unroll
        for (int ai = 0; ai < 2; ++ai)
#pragma unroll
            for (int m = 0; m < 4; ++m) { const int r = r0 + ai * HALF + m * 16;
                const f32x4 g0 = acc[ai][0][m][0] * s, g1 = acc[ai][0][m][1] * s, u0 = acc[ai][1][m][0] * s, u1 = acc[ai][1][m][1] * s;
                float o[8];
#pragma unroll
                for (int j = 0; j < 4; ++j) { o[j] = g0[j] * sigmoidf_(g0[j]) * u0[j]; o[4 + j] = g1[j] * sigmoidf_(g1[j]) * u1[j]; }
                u32x2 w; w.x = pack4_e4m3(o[0], o[1], o[2], o[3], F8A_SCALE); w.y = pack4_e4m3(o[4], o[5], o[6], o[7], F8A_SCALE);
                *(u32x2*)(act + (unsigned)((u.pm * BM + r) * 256 + colo)) = w; }
    }
};

constexpr float YS_SCALE = 16.0f, YS_INV = 1.0f / 16.0f;
__device__ __forceinline__ unsigned pack4_fp8(const f32x4 v, const float sc) {
    const float c0 = __builtin_amdgcn_fmed3f(v[0] * sc, -440.f, 440.f), c1 = __builtin_amdgcn_fmed3f(v[1] * sc, -440.f, 440.f), c2 = __builtin_amdgcn_fmed3f(v[2] * sc, -440.f, 440.f), c3 = __builtin_amdgcn_fmed3f(v[3] * sc, -440.f, 440.f);
    int r = __builtin_amdgcn_cvt_pk_fp8_f32(c0, c1, 0, false); r = __builtin_amdgcn_cvt_pk_fp8_f32(c2, c3, r, true); return (unsigned)r;
}
struct EpiMoe2 {
    static constexpr bool PERM = true; static constexpr bool MIDK = false;
    MoeTab tb; unsigned char* ys; float ysc;
    __device__ __forceinline__ void operator()(AccRef acc, const Unit& u, int wr, int wc, int fr, int fq) const {
        const int e = tb.tile_e[u.pm], p0 = tb.tile_p0[u.pm], cnt = (e == NEXP) ? NTOK : tb.cnt[e];
        const int yb = (e == NEXP) ? NTOK * 8 : tb.yoff[e];
        const int pnl = u.pn & 3;
        const int r0 = wr * 64 + fr, gran = ((pnl * 4 + wc) * 4 + fq) * 16;
#pragma unroll
        for (int ai = 0; ai < 2; ++ai)
#pragma unroll
            for (int m = 0; m < 4; ++m) { const int p = p0 + r0 + ai * HALF + m * 16;
                if (p < cnt) { u32x4 w; w.x = pack4_fp8(acc[ai][0][m][0], ysc); w.y = pack4_fp8(acc[ai][0][m][1], ysc); w.z = pack4_fp8(acc[ai][1][m][0], ysc); w.w = pack4_fp8(acc[ai][1][m][1], ysc);
                    *(u32x4*)(ys + (unsigned)((yb + p) * 1024 + gran)) = w; } }
    }
};
}
constexpr int NWAVES = 8, NTHR = 512;
constexpr int RING_BYTES = 131072, TAB_OFF = RING_BYTES, LDS_BYTES = 148480;
constexpr int NPHASE = 12;

struct Args {
    const float *x, *c, *w_ada, *b_ada, *w_in, *w_gup, *b_gate, *norm_w, *w_bsb, *w_bgla, *w_out, *ln1_g, *ln1_b, *w_router, *r_bias, *w_egu, *w_edn, *w_sgu, *w_sdn, *ln2_g, *ln2_b;
    float* out; unsigned char* ws; int ph_lo, ph_hi;
};

struct Frame { LAS unsigned char* lds; int tid, lane, wave, G, bid; };

__device__ __forceinline__ void titem_load(const float* W, int N, int item, int lane, f32x4 (&v)[16]) {
    const int nblk = (N + 63) / 64, kb = item / nblk, nb = item % nblk, k0 = 64 * kb + 16 * (lane >> 4), n = 64 * nb + 4 * (lane & 15);
    if (n < N) { const float* src = W + (size_t)k0 * N + n;
#pragma unroll
        for (int i = 0; i < 16; ++i) v[i] = __builtin_nontemporal_load((const f32x4*)(src + (size_t)i * N)); }
}
template <class RowMap>
__device__ __forceinline__ void titem_store(int N, int item, int lane, const f32x4 (&v)[16], const RowMap& rm) {
    const int nblk = (N + 63) / 64, kb = item / nblk, nb = item % nblk, k0 = 64 * kb + 16 * (lane >> 4), n = 64 * nb + 4 * (lane & 15);
    if (n < N) {
#pragma unroll
        for (int c = 0; c < 4; ++c) { bf16_t* dst = rm(n + c) + k0;
#pragma unroll
            for (int j = 0; j < 2; ++j) { u32x4 o; o.x = pk2(v[8 * j][c], v[8 * j + 1][c]); o.y = pk2(v[8 * j + 2][c], v[8 * j + 3][c]); o.z = pk2(v[8 * j + 4][c], v[8 * j + 5][c]); o.w = pk2(v[8 * j + 6][c], v[8 * j + 7][c]);
                *(u32x4*)(dst + 8 * j) = o; } }
    }
}
template <class RowMap8>
__device__ __forceinline__ void titem_store8(int N, int item, int lane, const f32x4 (&v)[16], const RowMap8& rm) {
    const int nblk = (N + 63) / 64, kb = item / nblk, nb = item % nblk, k0 = 64 * kb + 16 * (lane >> 4), n = 64 * nb + 4 * (lane & 15);
    if (n < N) {
#pragma unroll
        for (int c = 0; c < 4; ++c) { u32x4 o;
            o.x = pack4_e4m3(v[0][c], v[1][c], v[2][c], v[3][c], F8W_SCALE); o.y = pack4_e4m3(v[4][c], v[5][c], v[6][c], v[7][c], F8W_SCALE);
            o.z = pack4_e4m3(v[8][c], v[9][c], v[10][c], v[11][c], F8W_SCALE); o.w = pack4_e4m3(v[12][c], v[13][c], v[14][c], v[15][c], F8W_SCALE);
            *(u32x4*)(rm(n + c) + k0) = o; }
    }
}
struct RmGu8 { unsigned char* d; __device__ __forceinline__ unsigned char* operator()(int n) const {
    const int r = n < 256 ? ((n >> 7) * 256 + (n & 127)) : (((n - 256) >> 7) * 256 + 128 + ((n - 256) & 127)); return d + (size_t)r * DM; } };
struct RmPlain8 { unsigned char* d; int K; __device__ __forceinline__ unsigned char* operator()(int n) const { return d + (size_t)n * K; } };
struct RmPlain { bf16_t* d; int K; __device__ __forceinline__ bf16_t* operator()(int n) const { return d + (size_t)n * K; } };
struct RmWin { bf16_t* win; bf16_t* wglr; bf16_t* wv; __device__ __forceinline__ bf16_t* operator()(int n) const {
    if (n < 1024) return win + (size_t)n * DM;
    if (n < 1536) return wv + (size_t)(n - 1024) * DM;
    if (n < 2048) return win + (size_t)(n - 512) * DM;
    if (n < 2560) return wv + (size_t)(n - 2048 + 512) * DM;
    if (n < 3072) return win + (size_t)(n - 1024) * DM;
    if (n < 3088) return wglr + (size_t)(n - 3072) * DM;
    return win + (size_t)(n - 3088 + 2048) * DM; } };
struct RmGu { bf16_t* d; __device__ __forceinline__ bf16_t* operator()(int n) const {
    const int r = n < 256 ? ((n >> 7) * 256 + (n & 127)) : (((n - 256) >> 7) * 256 + 128 + ((n - 256) & 127)); return d + (size_t)r * DM; } };

constexpr int MI_GU1 = 16 * 8, MI_GU = 64 * MI_GU1, MI_DN1 = 4 * 16, MI_DN = 64 * MI_DN1, MOE_ITEMS = MI_GU + MI_GU1 + MI_DN + MI_DN1;
__device__ __forceinline__ void moe_item_load(const Args& a, int it, int lane, f32x4 (&v)[16]) {
    if (it < MI_GU) titem_load(a.w_egu + (size_t)(it / MI_GU1) * DM * 512, 512, it % MI_GU1, lane, v);
    else if (it < MI_GU + MI_GU1) titem_load(a.w_sgu, 512, it - MI_GU, lane, v);
    else if (it < MI_GU + MI_GU1 + MI_DN) { const int r = it - (MI_GU + MI_GU1); titem_load(a.w_edn + (size_t)(r / MI_DN1) * 256 * DM, DM, r % MI_DN1, lane, v); }
    else titem_load(a.w_sdn, DM, it - (MI_GU + MI_GU1 + MI_DN), lane, v);
}
__device__ __forceinline__ void moe_item_store(const Args& a, int it, int lane, const f32x4 (&v)[16]) {
    unsigned char* WGU8 = a.ws + WS_WGU; unsigned char* WDN8 = a.ws + WS_WDN;
    if (it < MI_GU) titem_store8(512, it % MI_GU1, lane, v, RmGu8{WGU8 + (size_t)(it / MI_GU1) * 512 * DM});
    else if (it < MI_GU + MI_GU1) titem_store8(512, it - MI_GU, lane, v, RmGu8{WGU8 + (size_t)64 * 512 * DM});
    else if (it < MI_GU + MI_GU1 + MI_DN) { const int r = it - (MI_GU + MI_GU1); titem_store8(DM, r % MI_DN1, lane, v, RmPlain8{WDN8 + (size_t)(r / MI_DN1) * DM * 256, 256}); }
    else titem_store8(DM, it - (MI_GU + MI_GU1 + MI_DN), lane, v, RmPlain8{WDN8 + (size_t)64 * DM * 256, 256});
}

struct MoeIt { const float* src; unsigned char* dst; int N, pitch, kb, nb; bool gu; };
__device__ __forceinline__ MoeIt moe_item_decode(const Args& a, int it) {
    const bool isgu = it < MI_GU + MI_GU1;
    const int r = isgu ? it : it - (MI_GU + MI_GU1), per = isgu ? MI_GU1 : MI_DN1, e = r / per, item = r % per;
    MoeIt m; m.gu = isgu; m.N = isgu ? 512 : DM; m.pitch = isgu ? DM : 256;
    const float* se = isgu ? a.w_egu : a.w_edn; const float* ss = isgu ? a.w_sgu : a.w_sdn;
    m.src = (e < 64) ? se + (size_t)e * (isgu ? DM * 512 : 256 * DM) : ss;
    m.dst = a.ws + (isgu ? WS_WGU : WS_WDN) + (size_t)e * (isgu ? 512 * DM : DM * 256);
    const int nblk = m.N >> 6; m.kb = item / nblk; m.nb = item % nblk; return m;
}
__device__ __forceinline__ void moe_item_load_u(const MoeIt& m, bool have, int lane, f32x4 (&v)[16]) {
    const int k0 = 64 * m.kb + 16 * (lane >> 4), n = 64 * m.nb + 4 * (lane & 15), Ne = have ? m.N : 0;
    const float* p = have ? m.src + (size_t)k0 * m.N + n : m.src;
#pragma unroll
    for (int i = 0; i < 16; ++i) v[i] = __builtin_nontemporal_load((const f32x4*)(p + (size_t)i * Ne));
}
__device__ __forceinline__ void moe_item_store_u(const MoeIt& m, bool have, int lane, const f32x4 (&v)[16], unsigned char* dummy) {
    const int k0 = 64 * m.kb + 16 * (lane >> 4), n = 64 * m.nb + 4 * (lane & 15);
#pragma unroll
    for (int c = 0; c < 4; ++c) { const int nn = n + c;
        const int r = m.gu ? (nn < 256 ? ((nn >> 7) * 256 + (nn & 127)) : (((nn - 256) >> 7) * 256 + 128 + ((nn - 256) & 127))) : nn;
        unsigned char* d = have ? m.dst + (size_t)r * m.pitch + k0 : dummy + 16 * c;
        u32x4 o;
        o.x = pack4_e4m3(v[0][c], v[1][c], v[2][c], v[3][c], F8W_SCALE); o.y = pack4_e4m3(v[4][c], v[5][c], v[6][c], v[7][c], F8W_SCALE);
        o.z = pack4_e4m3(v[8][c], v[9][c], v[10][c], v[11][c], F8W_SCALE); o.w = pack4_e4m3(v[12][c], v[13][c], v[14][c], v[15][c], F8W_SCALE);
        *(u32x4*)d = o; }
}

__device__ __forceinline__ void p0_phase(Frame& F, const Args& a) {
    unsigned char* ws = a.ws;
    if (F.bid < 96) {
        LAS float* sc = (LAS float*)F.lds;
        LAS float* red = (LAS float*)(F.lds + 32768);
        for (int i = F.tid; i < NB * DM; i += NTHR) { const float v = a.c[i]; sc[i] = v * sigmoidf_(v); }
        __syncthreads();
        const int col = F.bid * 64 + (F.tid & 63), kg = F.tid >> 6;
        float acc[8];
#pragma unroll
        for (int b = 0; b < 8; ++b) acc[b] = 0.f;
        for (int k = kg * 128; k < kg * 128 + 128; k += 16) { float w[16];
#pragma unroll
            for (int i = 0; i < 16; ++i) w[i] = a.w_ada[(size_t)(k + i) * 6144 + col];
#pragma unroll
            for (int i = 0; i < 16; ++i)
#pragma unroll
                for (int b = 0; b < 8; ++b) acc[b] += sc[b * DM + k + i] * w[i]; }
#pragma unroll
        for (int b = 0; b < 8; ++b) red[(kg * 8 + b) * 64 + (F.tid & 63)] = acc[b];
        __syncthreads();
        { const int b = F.tid >> 6, cl = F.tid & 63; float s = a.b_ada[F.bid * 64 + cl];
#pragma unroll
          for (int g = 0; g < 8; ++g) s += red[(g * 8 + b) * 64 + cl];
          ((float*)(ws + WS_MOD))[b * 6144 + F.bid * 64 + cl] = s; }
        __syncthreads();
    }
    const int gw = F.bid * NWAVES + F.wave, NGW = F.G * NWAVES;
    bf16_t* WIN = (bf16_t*)(ws + WS_WIN); bf16_t* WGLR = (bf16_t*)(ws + WS_WSM); bf16_t* WR = (bf16_t*)(ws + WS_WSM + 65536);
    constexpr int I_IN = 16 * 81, I_B = 8 * 16, I_O = 16 * 16, I_R = 16 * 1;
    constexpr int NITEMS = I_IN + 2 * I_B + I_O + I_R;
    for (int it = gw; it < NITEMS; it += NGW) {
        int r = it; f32x4 v[16];
        if (r < I_IN) { titem_load(a.w_in, 5136, r, F.lane, v); titem_store(5136, r, F.lane, v, RmWin{WIN, WGLR, (bf16_t*)(ws + WS_WV)}); continue; } r -= I_IN;
        if (r < I_B) { titem_load(a.w_bsb, DM, r, F.lane, v); titem_store(DM, r, F.lane, v, RmPlain{(bf16_t*)(ws + WS_WCAT), DM}); continue; } r -= I_B;
        if (r < I_B) { titem_load(a.w_bgla, DM, r, F.lane, v); titem_store(DM, r, F.lane, v, RmPlain{(bf16_t*)(ws + WS_WCAT) + 512, DM}); continue; } r -= I_B;
        if (r < I_O) { titem_load(a.w_out, DM, r, F.lane, v); titem_store(DM, r, F.lane, v, RmPlain{(bf16_t*)(ws + WS_WOUT), DM}); continue; } r -= I_O;
        titem_load(a.w_router, 64, r, F.lane, v); titem_store(64, r, F.lane, v, RmPlain{WR, DM});
    }
}

__device__ __forceinline__ void p1_phase(Frame& F, const Args& a) {
    const float* mod = (const float*)(a.ws + WS_MOD); bf16_t* H = (bf16_t*)(a.ws + WS_H1);
    const int gw = F.bid * NWAVES + F.wave, NGW = F.G * NWAVES;
    for (int m0 = gw * 8; m0 < NTOK; m0 += NGW * 8) {
        const int b = m0 >> 11;
        f32x4 sh[4], sc[4];
#pragma unroll
        for (int j = 0; j < 4; ++j) { sh[j] = *((const f32x4*)(mod + b * 6144) + F.lane + 64 * j); sc[j] = *((const f32x4*)(mod + b * 6144 + DM) + F.lane + 64 * j) + 1.0f; }
#pragma unroll
        for (int h4 = 0; h4 < 2; ++h4) {
            f32x4 v[4][4];
#pragma unroll
            for (int r = 0; r < 4; ++r) { const f32x4* xr = (const f32x4*)(a.x + (size_t)(m0 + 4 * h4 + r) * DM) + F.lane;
#pragma unroll
                for (int j = 0; j < 4; ++j) v[r][j] = xr[64 * j]; }
#pragma unroll
            for (int r = 0; r < 4; ++r) {
                const int m = m0 + 4 * h4 + r; float s = 0.f;
#pragma unroll
                for (int j = 0; j < 4; ++j) s += (v[r][j].x + v[r][j].y) + (v[r][j].z + v[r][j].w);
                const float mean = wave_sum(s) * (1.f / DM); float s2 = 0.f;
#pragma unroll
                for (int j = 0; j < 4; ++j) { v[r][j] = v[r][j] - mean; s2 += (v[r][j].x * v[r][j].x + v[r][j].y * v[r][j].y) + (v[r][j].z * v[r][j].z + v[r][j].w * v[r][j].w); }
                const float rstd = 1.f / sqrtf(wave_sum(s2) * (1.f / DM) + LN_EPS);
                u32x2* o8 = (u32x2*)(H + (size_t)m * DM) + F.lane;
#pragma unroll
                for (int j = 0; j < 4; ++j) { const f32x4 y = v[r][j] * rstd * sc[j] + sh[j]; u32x2 w; w.x = pk2(y.x, y.y); w.y = pk2(y.z, y.w); o8[64 * j] = w; }
            }
        }
    }
}

__device__ __forceinline__ void glr_tile(Frame& F, const Args& a, int tile) {
    const bf16_t* H = (const bf16_t*)(a.ws + WS_H1); const bf16_t* W = (const bf16_t*)(a.ws + WS_WSM); float* GLR = (float*)(a.ws + WS_GLR);
    const int l15 = F.lane & 15, q = F.lane >> 4;
    const bf16_t* ap = H + (size_t)(tile * 16 + l15) * DM + 8 * q; const bf16_t* bp = W + (size_t)l15 * DM + 8 * q;
    f32x4 acc = {0.f, 0.f, 0.f, 0.f};
#pragma unroll 4
    for (int k = 0; k < DM; k += 32) acc = __builtin_amdgcn_mfma_f32_16x16x32_bf16(*(const bf16x8*)(ap + k), *(const bf16x8*)(bp + k), acc, 0, 0, 0);
#pragma unroll
    for (int r = 0; r < 4; ++r) GLR[(size_t)(tile * 16 + q * 4 + r) * 16 + l15] = acc[r];
}

__device__ __forceinline__ int crow(int r, int hi) { return (r & 3) + 8 * (r >> 2) + 4 * hi; }
constexpr float SB_SKIP = -110.0f;
constexpr int SBK_ROW = 144, SBV_ROW = 80, SB_LDS = 32 * SBK_ROW + 64 * SBV_ROW;
template <bool SIDE = true>
__device__ __forceinline__ void sb_unit(int bh, int qb, const bf16_t* PROJ, const bf16_t* VT, bf16_t* OCAT, int lane, const Args& a, int& cit, int cstep, LAS unsigned char* ks, unsigned char* dummy) {
    LAS unsigned char* vs = ks + 32 * SBK_ROW;
    const int b = bh >> 3, h = bh & 7, r32 = lane & 31, hi = lane >> 5, q0 = qb * 32, q = q0 + r32;
    const size_t rowbase = (size_t)b * SEQ;
    bf16x8 qf[4];
    { const bf16_t* qp = PROJ + (rowbase + q) * PW + C_QSB + h * 64 + hi * 8;
#pragma unroll
      for (int s = 0; s < 4; ++s) qf[s] = *(const bf16x8*)(qp + 16 * s); }
    float carry = 0.f;
    f32x16 o0, o1;
#pragma unroll
    for (int r = 0; r < 16; ++r) { o0[r] = 0.f; o1[r] = 0.f; }
    const bf16_t* kg0 = PROJ + (rowbase + (lane >> 3)) * PW + C_KSB + h * 64 + 8 * (lane & 7);
    const bf16_t* vg0 = VT + ((size_t)b * 1024 + h * 64 + (lane >> 2)) * SEQ + 8 * (lane & 3);
    const LAS unsigned char* kfrag = ks + r32 * SBK_ROW + 16 * hi;
    const LAS unsigned char* vfrag = vs + r32 * SBV_ROW + 8 * hi;
    u32x4 kn[4], vn[4];
#define SB_LOAD(kb_) do { _Pragma("unroll") for (int i = 0; i < 4; ++i) { kn[i] = *(const u32x4*)(kg0 + (size_t)((kb_) * 32 + 8 * i) * PW); vn[i] = *(const u32x4*)(vg0 + (size_t)(16 * i) * SEQ + (kb_) * 32); } } while (0)
    SB_LOAD(qb);
    for (int kb = qb; kb >= 0; --kb) {
        const int k0 = kb * 32;
        const bool have = (cit < MOE_ITEMS); f32x4 cv[16];
        MoeIt mi;
        if constexpr (SIDE) { mi = moe_item_decode(a, cit < MOE_ITEMS ? cit : MOE_ITEMS - 1); moe_item_load_u(mi, have, lane, cv); }
#pragma unroll
        for (int i = 0; i < 4; ++i) { *(LAS u32x4*)(ks + (8 * i + (lane >> 3)) * SBK_ROW + 16 * (lane & 7)) = kn[i]; *(LAS u32x4*)(vs + (16 * i + (lane >> 2)) * SBV_ROW + 16 * (lane & 3)) = vn[i]; }
        LDS_WAIT(); asm volatile("" ::: "memory");
        SB_LOAD(kb > 0 ? kb - 1 : 0);
        bf16x8 kc[4]; u32x2 vc[2][2][2];
#pragma unroll
        for (int s = 0; s < 4; ++s) kc[s] = *(const LAS bf16x8*)(kfrag + 32 * s);
#pragma unroll
        for (int s = 0; s < 2; ++s)
#pragma unroll
            for (int d0 = 0; d0 < 2; ++d0) { vc[s][d0][0] = *(const LAS u32x2*)(vfrag + 32 * SBV_ROW * d0 + 32 * s); vc[s][d0][1] = *(const LAS u32x2*)(vfrag + 32 * SBV_ROW * d0 + 32 * s + 16); }
        LDS_WAIT(); asm volatile("" ::: "memory");
        f32x16 p;
#pragma unroll
        for (int r = 0; r < 16; ++r) p[r] = 0.f;
#pragma unroll
        for (int s = 0; s < 4; ++s) p = __builtin_amdgcn_mfma_f32_32x32x16_bf16(kc[s], qf[s], p, 0, 0, 0);
        float lb[16], l1[16];
        const bool diag = (kb == qb);
#pragma unroll
        for (int r = 0; r < 16; ++r) {
            const float z = p[r] * 0.125f;
            const float t = flog(1.0f + fexp(-fabsf(z)));
            lb[r] = fminf(z, 0.f) - t; l1[r] = fminf(-z, 0.f) - t;
            if (diag) { const bool valid = (k0 + crow(r, hi)) < q; if (!valid) { lb[r] = -INFINITY; l1[r] = 0.f; } }
        }
        float G[4], PG[4];
#pragma unroll
        for (int g = 0; g < 4; ++g) { G[g] = (l1[4 * g] + l1[4 * g + 1]) + (l1[4 * g + 2] + l1[4 * g + 3]);
            const auto rr = __builtin_amdgcn_permlane32_swap(__builtin_bit_cast(unsigned, G[g]), __builtin_bit_cast(unsigned, G[g]), false, false);
            PG[g] = __builtin_bit_cast(float, hi ? rr[0] : rr[1]); }
        float T[4]; T[3] = 0.f;
#pragma unroll
        for (int g = 2; g >= 0; --g) T[g] = T[g + 1] + G[g + 1] + PG[g + 1];
        float w[16];
#pragma unroll
        for (int g = 0; g < 4; ++g) {
            const float base = carry + T[g] + (hi == 0 ? PG[g] : 0.f);
            const float s3 = l1[4 * g + 3], s2 = s3 + l1[4 * g + 2], s1 = s2 + l1[4 * g + 1];
            w[4 * g + 3] = fexp(lb[4 * g + 3] + base);
            w[4 * g + 2] = fexp(lb[4 * g + 2] + base + s3);
            w[4 * g + 1] = fexp(lb[4 * g + 1] + base + s2);
            w[4 * g + 0] = fexp(lb[4 * g + 0] + base + s1);
        }
        carry += (T[0] + G[0] + PG[0]);
#pragma unroll
        for (int s = 0; s < 2; ++s) {
            u32x4 wb; wb.x = pk2(w[8 * s], w[8 * s + 1]); wb.y = pk2(w[8 * s + 2], w[8 * s + 3]); wb.z = pk2(w[8 * s + 4], w[8 * s + 5]); wb.w = pk2(w[8 * s + 6], w[8 * s + 7]);
            const bf16x8 wf = __builtin_bit_cast(bf16x8, wb);
            { u32x4 av; av.x = vc[s][0][0].x; av.y = vc[s][0][0].y; av.z = vc[s][0][1].x; av.w = vc[s][0][1].y; o0 = __builtin_amdgcn_mfma_f32_32x32x16_bf16(__builtin_bit_cast(bf16x8, av), wf, o0, 0, 0, 0); }
            { u32x4 av; av.x = vc[s][1][0].x; av.y = vc[s][1][0].y; av.z = vc[s][1][1].x; av.w = vc[s][1][1].y; o1 = __builtin_amdgcn_mfma_f32_32x32x16_bf16(__builtin_bit_cast(bf16x8, av), wf, o1, 0, 0, 0); }
        }
        if constexpr (SIDE) { moe_item_store_u(mi, have, lane, cv, dummy); cit += have ? cstep : 0; }
        if (__all(carry < SB_SKIP)) break;
    }
#undef SB_LOAD
    bf16_t* op = OCAT + (rowbase + q) * DM + h * 64 + 4 * hi;
#pragma unroll
    for (int g = 0; g < 4; ++g) {
        u32x2 w0; w0.x = pk2(o0[4 * g], o0[4 * g + 1]); w0.y = pk2(o0[4 * g + 2], o0[4 * g + 3]); *(u32x2*)(op + 8 * g) = w0;
        u32x2 w1; w1.x = pk2(o1[4 * g], o1[4 * g + 1]); w1.y = pk2(o1[4 * g + 2], o1[4 * g + 3]); *(u32x2*)(op + 32 + 8 * g) = w1;
    }
}

constexpr int GL_GA = 0, GL_GLR = 16384, GL_WUP = 20480, GL_GS = 24576, GL_QS = 26624, GL_KD = 35840, GL_KLT = 45056, GL_PP = 54272, GL_RMS = 63488, GLS = 72;
struct PrepIn { float glr[2], wup[2], bias; };
__device__ __forceinline__ void prep_load(Frame& F, const Args& a, int bh, int c, PrepIn& P) {
    const int b = bh >> 2, h = bh & 3, tok0 = b * SEQ + c * 64;
    const float* GLR = (const float*)(a.ws + WS_GLR);
#pragma unroll
    for (int k = 0; k < 2; ++k) { const int i = F.tid + k * NTHR; P.glr[k] = GLR[(size_t)tok0 * 16 + i]; P.wup[k] = a.w_gup[(i >> 6) * 256 + h * 64 + (i & 63)]; }
    P.bias = a.b_gate[h * 64 + (F.tid & 63)];
}
__device__ __forceinline__ void gla_prep(Frame& F, const Args& a, int bh, int c, const PrepIn& P) {
    const int h = bh & 3;
    LAS float* GAm = (LAS float*)(F.lds + GL_GA); LAS float* GLRs = (LAS float*)(F.lds + GL_GLR); LAS float* WUP = (LAS float*)(F.lds + GL_WUP); LAS float* GS = (LAS float*)(F.lds + GL_GS);
#pragma unroll
    for (int k = 0; k < 2; ++k) { const int i = F.tid + k * NTHR; GLRs[i] = P.glr[k]; WUP[i] = P.wup[k]; }
    __syncthreads();
    const int d = F.tid & 63, tg = F.tid >> 6;
    float wcol[16];
#pragma unroll
    for (int r = 0; r < 16; ++r) wcol[r] = WUP[r * 64 + d];
    const float bias = P.bias; (void)h;
    float loc[8]; float run = 0.f;
#pragma unroll
    for (int i = 0; i < 8; ++i) { const int t = tg * 8 + i; float xv = bias;
#pragma unroll
        for (int r = 0; r < 16; ++r) xv += GLRs[t * 16 + r] * wcol[r];
        run += logsigmoid_(xv) * (1.0f / 16.0f); loc[i] = run; }
    GS[tg * 64 + d] = run;
    __syncthreads();
    float pre = 0.f;
#pragma unroll
    for (int g = 0; g < 8; ++g) pre += (g < tg) ? GS[g * 64 + d] : 0.f;
#pragma unroll
    for (int i = 0; i < 8; ++i) GAm[(tg * 8 + i) * 64 + d] = loc[i] + pre;
    __syncthreads();
}
struct G1In { unsigned short kraw[8]; bf16x8 a0, a1; PrepIn P; };
__device__ __forceinline__ void g1_load(Frame& F, const Args& a, int unit, G1In& R) {
    const int bh = unit >> 5, c = unit & 31, b = bh >> 2, h = bh & 3, tok0 = b * SEQ + c * 64;
    const bf16_t* PROJ = (const bf16_t*)(a.ws + WS_PROJ); const bf16_t* VTG = (const bf16_t*)(a.ws + WS_VT) + ((size_t)b * 1024 + 512 + h * 128) * SEQ;
    const int d = F.tid & 63, tg = F.tid >> 6, l15 = F.lane & 15, q = F.lane >> 4;
#pragma unroll
    for (int i = 0; i < 8; ++i) R.kraw[i] = PROJ[(size_t)(tok0 + tg * 8 + i) * PW + C_KG + h * 64 + d];
    const bf16_t* ap = VTG + ((size_t)16 * F.wave + l15) * SEQ + c * 64 + 8 * q;
    R.a0 = *(const bf16x8*)ap; R.a1 = *(const bf16x8*)(ap + 32);
    prep_load(F, a, bh, c, R.P);
}
__device__ __forceinline__ void gla_g1(Frame& F, const Args& a, int unit, const G1In& R) {
    const int bh = unit >> 5, c = unit & 31;
    LAS float* GAm = (LAS float*)(F.lds + GL_GA); LAS bf16_t* KLT = (LAS bf16_t*)(F.lds + GL_KLT);
    float* KVT = (float*)(a.ws + WS_KVT); float* DEC = (float*)(a.ws + WS_DEC);
    const int d = F.tid & 63, tg = F.tid >> 6, l15 = F.lane & 15, q = F.lane >> 4;
    const bf16x8 a0 = R.a0, a1 = R.a1;
    gla_prep(F, a, bh, c, R.P);
    const float glast = GAm[63 * 64 + d];
#pragma unroll
    for (int i = 0; i < 8; ++i) { const int t = tg * 8 + i; KLT[d * GLS + t] = (bf16_t)f2bf(bf2f(R.kraw[i]) * fexp(glast - GAm[t * 64 + d])); }
    if (tg == 0) DEC[unit * 64 + d] = fexp(glast);
    __syncthreads();
#pragma unroll
    for (int tn = 0; tn < 4; ++tn) {
        const LAS bf16_t* bp = KLT + (16 * tn + l15) * GLS + 8 * q;
        f32x4 acc = {0.f, 0.f, 0.f, 0.f};
        acc = __builtin_amdgcn_mfma_f32_16x16x32_bf16(a0, *(const LAS bf16x8*)bp, acc, 0, 0, 0);
        acc = __builtin_amdgcn_mfma_f32_16x16x32_bf16(a1, *(const LAS bf16x8*)(bp + 32), acc, 0, 0, 0);
#pragma unroll
        for (int r = 0; r < 4; ++r) KVT[((size_t)unit * 128 + 16 * F.wave + q * 4 + r) * 64 + 16 * tn + l15] = acc[r];
    }
    __syncthreads();
}
__device__ __forceinline__ void gla_scan(Frame& F, const Args& a) {
    const float* KVT = (const float*)(a.ws + WS_KVT); const float* DEC = (const float*)(a.ws + WS_DEC); bf16_t* ST = (bf16_t*)(a.ws + WS_ST16);
    for (int e = F.bid * NTHR + F.tid; e < 32 * 8192; e += F.G * NTHR) {
        const int bh = e >> 13, rem = e & 8191, d = rem & 63; float S = 0.f;
        for (int c = 0; c < 32; ++c) { const int unit = bh * 32 + c; const float kv = KVT[(size_t)unit * 8192 + rem];
            ST[(size_t)unit * 8192 + rem] = (bf16_t)f2bf(S); S = DEC[unit * 64 + d] * S + kv; }
    }
}
struct G3In { unsigned short qraw[8], kraw[8], rgraw[4][4]; bf16x8 bv0, bv1, bs0, bs1; PrepIn P; };
__device__ __forceinline__ void g3_load(Frame& F, const Args& a, int unit, G3In& R) {
    const int bh = unit >> 5, c = unit & 31, b = bh >> 2, h = bh & 3, tok0 = b * SEQ + c * 64;
    const bf16_t* PROJ = (const bf16_t*)(a.ws + WS_PROJ); const bf16_t* VTG = (const bf16_t*)(a.ws + WS_VT) + ((size_t)b * 1024 + 512 + h * 128) * SEQ; const bf16_t* ST = (const bf16_t*)(a.ws + WS_ST16);
    const int l15 = F.lane & 15, q = F.lane >> 4;
    { const int d = F.tid & 63, tg = F.tid >> 6;
#pragma unroll
      for (int i = 0; i < 8; ++i) { const size_t ro = (size_t)(tok0 + tg * 8 + i) * PW + h * 64 + d; R.qraw[i] = PROJ[ro + C_QG]; R.kraw[i] = PROJ[ro + C_KG]; } }
    const bf16_t* vp_ = VTG + ((size_t)16 * F.wave + l15) * SEQ + c * 64 + 8 * q; const bf16_t* sp_ = ST + ((size_t)unit * 128 + 16 * F.wave + l15) * 64 + 8 * q;
    R.bv0 = *(const bf16x8*)vp_; R.bv1 = *(const bf16x8*)(vp_ + 32); R.bs0 = *(const bf16x8*)sp_; R.bs1 = *(const bf16x8*)(sp_ + 32);
#pragma unroll
    for (int tm = 0; tm < 4; ++tm)
#pragma unroll
        for (int r = 0; r < 4; ++r) R.rgraw[tm][r] = PROJ[(size_t)(tok0 + 16 * tm + q * 4 + r) * PW + C_RG + h * 128 + 16 * F.wave + l15];
    prep_load(F, a, bh, c, R.P);
}
__device__ __forceinline__ void gla_g3(Frame& F, const Args& a, int unit, const G3In& R) {
    const int bh = unit >> 5, c = unit & 31, b = bh >> 2, h = bh & 3, tok0 = b * SEQ + c * 64;
    LAS float* GAm = (LAS float*)(F.lds + GL_GA); LAS bf16_t* QS = (LAS bf16_t*)(F.lds + GL_QS); LAS bf16_t* KD = (LAS bf16_t*)(F.lds + GL_KD); LAS bf16_t* PP = (LAS bf16_t*)(F.lds + GL_PP);
    LAS float* RMS = (LAS float*)(F.lds + GL_RMS);
    bf16_t* OG = (bf16_t*)(a.ws + WS_OCAT) + 512;
    const int l15 = F.lane & 15, q = F.lane >> 4;
    const bf16x8 bv0 = R.bv0, bv1 = R.bv1, bs0 = R.bs0, bs1 = R.bs1;
    gla_prep(F, a, bh, c, R.P);
    { const int d = F.tid & 63, tg = F.tid >> 6;
#pragma unroll
      for (int i = 0; i < 8; ++i) { const int t = tg * 8 + i; const float gv = GAm[t * 64 + d];
          QS[t * GLS + d] = (bf16_t)f2bf(bf2f(R.qraw[i]) * 0.125f * fexp(gv)); KD[t * GLS + d] = (bf16_t)f2bf(bf2f(R.kraw[i]) * fexp(-gv)); } }
    __syncthreads();
    { const int tm = F.wave >> 1; const LAS bf16_t* ap = QS + (16 * tm + l15) * GLS + 8 * q;
      const bf16x8 a0 = *(const LAS bf16x8*)ap, a1 = *(const LAS bf16x8*)(ap + 32);
#pragma unroll
      for (int j = 0; j < 2; ++j) { const int tn = (F.wave & 1) * 2 + j; const LAS bf16_t* bp = KD + (16 * tn + l15) * GLS + 8 * q;
          f32x4 acc = {0.f, 0.f, 0.f, 0.f};
          acc = __builtin_amdgcn_mfma_f32_16x16x32_bf16(a0, *(const LAS bf16x8*)bp, acc, 0, 0, 0);
          acc = __builtin_amdgcn_mfma_f32_16x16x32_bf16(a1, *(const LAS bf16x8*)(bp + 32), acc, 0, 0, 0);
#pragma unroll
          for (int r = 0; r < 4; ++r) { const int t = 16 * tm + q * 4 + r, s = 16 * tn + l15; PP[t * GLS + s] = (bf16_t)f2bf(s <= t ? acc[r] : 0.f); } } }
    __syncthreads();
    f32x4 acc[4];
    {
#pragma unroll
      for (int tm = 0; tm < 4; ++tm) { const LAS bf16_t* pp = PP + (16 * tm + l15) * GLS + 8 * q; const LAS bf16_t* qp = QS + (16 * tm + l15) * GLS + 8 * q;
          f32x4 c4 = {0.f, 0.f, 0.f, 0.f};
          c4 = __builtin_amdgcn_mfma_f32_16x16x32_bf16(*(const LAS bf16x8*)pp, bv0, c4, 0, 0, 0);
          c4 = __builtin_amdgcn_mfma_f32_16x16x32_bf16(*(const LAS bf16x8*)(pp + 32), bv1, c4, 0, 0, 0);
          c4 = __builtin_amdgcn_mfma_f32_16x16x32_bf16(*(const LAS bf16x8*)qp, bs0, c4, 0, 0, 0);
          c4 = __builtin_amdgcn_mfma_f32_16x16x32_bf16(*(const LAS bf16x8*)(qp + 32), bs1, c4, 0, 0, 0);
          acc[tm] = c4; } }
#pragma unroll
    for (int tm = 0; tm < 4; ++tm)
#pragma unroll
        for (int r = 0; r < 4; ++r) { float sq = acc[tm][r] * acc[tm][r];
            sq = row16_sum(sq);
            if (l15 == 0) RMS[F.wave * 64 + 16 * tm + q * 4 + r] = sq; }
    __syncthreads();
    const int dv = 16 * F.wave + l15; const float nw = a.norm_w[h * 128 + dv];
#pragma unroll
    for (int tm = 0; tm < 4; ++tm)
#pragma unroll
        for (int r = 0; r < 4; ++r) { const int t = 16 * tm + q * 4 + r; float ms = 0.f;
#pragma unroll
            for (int w = 0; w < 8; ++w) ms += RMS[w * 64 + t];
            const float rs = 1.0f / sqrtf(ms * (1.0f / 128.0f) + LN_EPS);
            const float rg = bf2f(R.rgraw[tm][r]);
            OG[(size_t)(tok0 + t) * DM + h * 128 + dv] = (bf16_t)f2bf(acc[tm][r] * rs * nw * (rg * sigmoidf_(rg))); }
    __syncthreads();
}
typedef GAS unsigned gu32;
#define RLX_AGENT __ATOMIC_RELAXED, __HIP_MEMORY_SCOPE_AGENT
#define XB_TMO      128
#define XB_XCNT(j)  (256  + 64 * (j))
#define XB_XSUB(j)  (1280 + 64 * (j))
#define XB_XGEN(j)  (2304 + 64 * (j))
#define XB_TOP      3328
#define XB_TOPGEN   3392
#define XCD_BAR_WORDS 3456
#define XB_SPIN_CAP (1u << 18)

__device__ __forceinline__ unsigned xb_ld(unsigned* p)              { return __hip_atomic_load(p, __ATOMIC_RELAXED, __HIP_MEMORY_SCOPE_AGENT); }
__device__ __forceinline__ unsigned xb_add(unsigned* p, unsigned v) { return __hip_atomic_fetch_add(p, v, __ATOMIC_RELAXED, __HIP_MEMORY_SCOPE_AGENT); }
__device__ __forceinline__ unsigned xb_xcc_id() { return (unsigned)__builtin_amdgcn_s_getreg((3 << 11) | 20) & 0xFu; }
#define XB_SPIN(cond, bar) do { unsigned _sp = 0; while (cond) { __builtin_amdgcn_s_sleep(1); \
    if ((++_sp & 255u) == 0u) { if (xb_ld(&(bar)[XB_TMO])) break; if (_sp > XB_SPIN_CAP) { atomicAdd(&(bar)[XB_TMO], 1u); break; } } } } while (0)

struct XcdBarrier {
    unsigned* bar; unsigned x;
    volatile LAS unsigned* st;
};

__device__ __forceinline__ XcdBarrier xcd_barrier_post(unsigned* bar, volatile LAS unsigned* st) {
    XcdBarrier b; b.bar = bar; b.x = xb_xcc_id(); b.st = st;
    if (threadIdx.x == 0) (void)xb_add(&bar[XB_XCNT(b.x)], 1u);
    return b;
}
__device__ __forceinline__ void xcd_barrier_complete(unsigned* bar, unsigned x, unsigned& nloc, unsigned& nx) {
    const unsigned G = gridDim.x * gridDim.y * gridDim.z;
    unsigned sum, cnt, mine, sp = 0u;
    for (;;) {
        sum = 0u; cnt = 0u; mine = 0u;
#pragma unroll
        for (unsigned j = 0; j < 16; ++j) { const unsigned c = xb_ld(&bar[XB_XCNT(j)]); sum += c; cnt += (c > 0u) ? 1u : 0u; mine = (j == x) ? c : mine; }
        if (sum == G) break;
        __builtin_amdgcn_s_sleep(1);
        if ((++sp & 255u) == 0u) { if (xb_ld(&bar[XB_TMO])) break; if (sp > XB_SPIN_CAP) { atomicAdd(&bar[XB_TMO], 1u); break; } }
    }
    nloc = mine > 0u ? mine : 1u; nx = cnt > 0u ? cnt : 1u;
}

__device__ __forceinline__ void xcd_barrier(const XcdBarrier& b) {
    asm volatile("s_waitcnt vmcnt(0)" ::: "memory");
    __syncthreads();
    if (threadIdx.x == 0) {
        unsigned* bar = b.bar;
        __builtin_amdgcn_s_waitcnt(0);
        unsigned nloc = b.st[0], nx = b.st[1];
        if (nloc == 0u) { xcd_barrier_complete(bar, b.x, nloc, nx); b.st[0] = nloc; b.st[1] = nx; }
        const unsigned old = xb_add(&bar[XB_XSUB(b.x)], 1u);
        const unsigned gen = old / nloc;
        if (old + 1u == (gen + 1u) * nloc) {
            __builtin_amdgcn_fence(__ATOMIC_RELEASE, "agent");
            asm volatile("s_waitcnt vmcnt(0)" ::: "memory");
            const unsigned og = xb_add(&bar[XB_TOP], 1u);
            const unsigned tg = og / nx;
            if (og + 1u == (tg + 1u) * nx) xb_add(&bar[XB_TOPGEN], 1u);
            else XB_SPIN(xb_ld(&bar[XB_TOPGEN]) == tg, bar);
            __builtin_amdgcn_fence(__ATOMIC_ACQUIRE, "agent");
            xb_add(&bar[XB_XGEN(b.x)], 1u);
            asm volatile("s_waitcnt vmcnt(0)" ::: "memory");
        } else {
            XB_SPIN(xb_ld(&bar[XB_XGEN(b.x)]) == gen, bar);
            __builtin_amdgcn_fence(__ATOMIC_ACQUIRE, "agent");
            asm volatile("s_waitcnt vmcnt(0)" ::: "memory");
        }
    }
    __syncthreads();
}

constexpr int ATS = 1032;
constexpr int P8_HIST = 64 * ATS * 2;
__device__ __forceinline__ void p8_phase(Frame& F, const Args& a) {
    const float* mod = (const float*)(a.ws + WS_MOD); bf16_t* H2 = (bf16_t*)(a.ws + WS_H2); const bf16_t* WR = (const bf16_t*)(a.ws + WS_WSM + 65536);
    float* X1 = a.out;
    unsigned* gcnt = (unsigned*)(a.ws + WS_CTL) + CW_CNT;     int* LIST = (int*)(a.ws + WS_LIST); float* WTOK = (float*)(a.ws + WS_GWT);     unsigned* SLOT = (unsigned*)(a.ws + WS_SLOT);
    LAS bf16_t* AT = (LAS bf16_t*)F.lds; LAS float* LG = (LAS float*)F.lds; LAS int* HIST = (LAS int*)(F.lds + P8_HIST); LAS int* BASE = HIST + 64;
    for (int blk = F.bid; blk < NTOK / 64; blk += F.G) {
        if (F.tid < 64) HIST[F.tid] = 0;
        int ln_ = F.lane; asm volatile("" : "+v"(ln_)); const float rb = a.r_bias[ln_];
        {
            const int m0 = blk * 64 + F.wave * 8, b = m0 >> 11;
            f32x4 va[8][4];
#pragma unroll
            for (int h4 = 0; h4 < 2; ++h4) { u32x2 gm[4][4];
#pragma unroll
                for (int i = 0; i < 4; ++i)
#pragma unroll
                    for (int j = 0; j < 4; ++j) { va[4 * h4 + i][j] = *((const f32x4*)(a.x + (size_t)(m0 + 4 * h4 + i) * DM) + F.lane + 64 * j);
                        gm[i][j] = *((const u32x2*)((const bf16_t*)(a.out + (size_t)(m0 + 4 * h4 + i) * DM)) + F.lane + 64 * j); }
#pragma unroll
                for (int i = 0; i < 4; ++i)
#pragma unroll
                    for (int j = 0; j < 4; ++j) va[4 * h4 + i][j] = va[4 * h4 + i][j] * DN_ALPHA + (f32x4){bflo(gm[i][j].x), bfhi(gm[i][j].x), bflo(gm[i][j].y), bfhi(gm[i][j].y)}; }
            f32x4 lg[4], lb[4], sh[4], sc[4];
#pragma unroll
            for (int j = 0; j < 4; ++j) { lg[j] = *((const f32x4*)a.ln1_g + F.lane + 64 * j); lb[j] = *((const f32x4*)a.ln1_b + F.lane + 64 * j);
                sh[j] = *((const f32x4*)(mod + b * 6144 + 3 * DM) + F.lane + 64 * j); sc[j] = *((const f32x4*)(mod + b * 6144 + 4 * DM) + F.lane + 64 * j) + 1.0f; }
#pragma unroll
            for (int i = 0; i < 8; ++i) {
                const int lr = F.wave * 8 + i, m = m0 + i;
                f32x4 v[4]; float s = 0.f;
#pragma unroll
                for (int j = 0; j < 4; ++j) { v[j] = va[i][j]; s += (v[j].x + v[j].y) + (v[j].z + v[j].w); }
                float mean = wave_sum(s) * (1.f / DM), s2 = 0.f;
#pragma unroll
                for (int j = 0; j < 4; ++j) { v[j] = v[j] - mean; s2 += (v[j].x * v[j].x + v[j].y * v[j].y) + (v[j].z * v[j].z + v[j].w * v[j].w); }
                float rstd = 1.f / sqrtf(wave_sum(s2) * (1.f / DM) + LN_EPS);
                s = 0.f;
#pragma unroll
                for (int j = 0; j < 4; ++j) { v[j] = v[j] * rstd * lg[j] + lb[j]; { u32x2 xw; xw.x = pk2(v[j].x, v[j].y); xw.y = pk2(v[j].z, v[j].w); *((u32x2*)(X1 + (size_t)m * DM) + F.lane + 64 * j) = xw; } s += (v[j].x + v[j].y) + (v[j].z + v[j].w); }
                mean = wave_sum(s) * (1.f / DM); s2 = 0.f;
#pragma unroll
                for (int j = 0; j < 4; ++j) { v[j] = v[j] - mean; s2 += (v[j].x * v[j].x + v[j].y * v[j].y) + (v[j].z * v[j].z + v[j].w * v[j].w); }
                rstd = 1.f / sqrtf(wave_sum(s2) * (1.f / DM) + LN_EPS);
                unsigned* o8 = (unsigned*)((unsigned char*)H2 + (size_t)m * DM) + F.lane; LAS u32x2* l8 = (LAS u32x2*)(AT + lr * ATS) + F.lane;
#pragma unroll
                for (int j = 0; j < 4; ++j) { const f32x4 y = v[j] * rstd * sc[j] + sh[j]; u32x2 w; w.x = pk2(y.x, y.y); w.y = pk2(y.z, y.w); o8[64 * j] = pack4_e4m3(y.x, y.y, y.z, y.w, F8H_SCALE); l8[64 * j] = w; }
            }
        }
        __syncthreads();
        int lb_ = F.lane; asm volatile("" : "+v"(lb_));
        const int l15 = lb_ & 15, q = lb_ >> 4, tn = F.wave & 3, tm0 = (F.wave >> 2) * 2;
        f32x4 lg0 = {0.f, 0.f, 0.f, 0.f}, lg1 = {0.f, 0.f, 0.f, 0.f};
        { const LAS bf16_t* ap0 = AT + (16 * tm0 + l15) * ATS + 8 * q; const LAS bf16_t* ap1 = ap0 + 16 * ATS; const bf16_t* bp = WR + (size_t)(16 * tn + l15) * DM + 8 * q;
#pragma unroll 8
          for (int k = 0; k < DM; k += 32) { const bf16x8 bv = *(const bf16x8*)(bp + k);
              lg0 = __builtin_amdgcn_mfma_f32_16x16x32_bf16(*(const LAS bf16x8*)(ap0 + k), bv, lg0, 0, 0, 0);
              lg1 = __builtin_amdgcn_mfma_f32_16x16x32_bf16(*(const LAS bf16x8*)(ap1 + k), bv, lg1, 0, 0, 0); } }
        __syncthreads();
#pragma unroll
        for (int r = 0; r < 4; ++r) { const int e0 = 16 * tn + l15; LG[(16 * tm0 + q * 4 + r) * 64 + e0] = lg0[r]; LG[(16 * (tm0 + 1) + q * 4 + r) * 64 + e0] = lg1[r]; }
        __syncthreads();
        const int e = F.lane;
        bool sel[8]; int ploc[8], rnk[8]; float wgt[8];
#pragma unroll
        for (int i = 0; i < 8; ++i) {
            const int lr = F.wave * 8 + i;
            const float score = sigmoidf_(LG[lr * 64 + e]); const float sv = score + rb;
            const float m1 = grp8_max(sv);
            const int i1 = grp8_min((sv == m1) ? e : 64);
            const float m2 = grp8_max((e == i1) ? -INFINITY : sv);
            const float gs = m1 + m2; const int g = e >> 3;
            int grank = 0;
#pragma unroll
            for (int j = 0; j < 8; ++j) { const float o = __builtin_bit_cast(float, __builtin_amdgcn_readlane(__builtin_bit_cast(int, gs), 8 * j)); grank += (o > gs || (o == gs && j < g)) ? 1 : 0; }
            const float sm = (grank < 4) ? sv : -INFINITY;
            int rank = 64; { float cur = sm;
#pragma unroll
              for (int k = 0; k < 8; ++k) { const float mx = wave_max(cur); const int idx = (int)__builtin_ctzll(__builtin_amdgcn_ballot_w64(cur == mx)); if (e == idx) { rank = k; cur = -INFINITY; } } }
            const bool s_ = rank < 8;
            const float wsum = wave_sum(s_ ? score : 0.f);
            sel[i] = s_; rnk[i] = rank; wgt[i] = score / wsum * ROUTED_SCALE;
            ploc[i] = s_ ? __hip_atomic_fetch_add(&HIST[e], 1, __ATOMIC_RELAXED, __HIP_MEMORY_SCOPE_WORKGROUP) : 0;
        }
        __syncthreads();
        { int t_ = F.tid; asm volatile("" : "+v"(t_));
          if (t_ < 64) BASE[t_] = (int)__hip_atomic_fetch_add(gcnt + 64 * t_, (unsigned)HIST[t_], __ATOMIC_RELAXED, __HIP_MEMORY_SCOPE_AGENT); }
        __syncthreads();
        const int base = BASE[e];
#pragma unroll
        for (int i = 0; i < 8; ++i) if (sel[i]) { const int m = blk * 64 + F.wave * 8 + i, p = base + ploc[i];
            LIST[(size_t)e * ECAP + p] = m; WTOK[(size_t)m * 8 + rnk[i]] = wgt[i]; SLOT[(size_t)m * 8 + rnk[i]] = ((unsigned)e << 16) | (unsigned)p; }
        __syncthreads();
    }
}

constexpr int TB_TE = TAB_OFF, TB_TP = TAB_OFF + 4096, TB_CNT = TAB_OFF + 8192, TB_YOFF = TAB_OFF + 8192 + 512, TB_NT = TAB_OFF + 8192 + 1024;
__device__ __forceinline__ int moe_tables(Frame& F, const Args& a) {
    const unsigned* gcnt = (const unsigned*)(a.ws + WS_CTL) + CW_CNT;
    LAS int* TE = (LAS int*)(F.lds + TB_TE); LAS int* TP = (LAS int*)(F.lds + TB_TP); LAS int* CNT = (LAS int*)(F.lds + TB_CNT); LAS int* YOFF = (LAS int*)(F.lds + TB_YOFF); LAS int* NT = (LAS int*)(F.lds + TB_NT);
    if (F.wave == 0) {
        const int e = F.lane;
        const int c = (int)__hip_atomic_load(gcnt + 64 * e, __ATOMIC_RELAXED, __HIP_MEMORY_SCOPE_AGENT), nt = (c + 255) >> 8;
        int st = nt, sy = c;
#pragma unroll
        for (int o = 1; o < 64; o <<= 1) { const int pt = __shfl_up(st, o), py = __shfl_up(sy, o); if (e >= o) { st += pt; sy += py; } }
        const int t0 = st - nt, y0 = sy - c;
        CNT[e] = c; YOFF[e] = y0;
        for (int j = 0; j < nt; ++j) { TE[t0 + j] = e; TP[t0 + j] = j * 256; }
        const int tsh = __shfl(st, 63), ysh = __shfl(sy, 63);
        TE[tsh + e] = NEXP; TP[tsh + e] = e * 256;
        if (e == 0) { CNT[NEXP] = NTOK; YOFF[NEXP] = ysh; NT[0] = tsh + NTOK / 256; }
    }
    __syncthreads();
    return __builtin_amdgcn_readfirstlane(NT[0]);
}

__device__ __forceinline__ void p11_phase(Frame& F, const Args& a, float* dst) {
    const float* mod = (const float*)(a.ws + WS_MOD); const unsigned char* YS = (const unsigned char*)(a.ws + WS_YS); const unsigned* SLOT = (const unsigned*)(a.ws + WS_SLOT); const float* WTOK = (const float*)(a.ws + WS_GWT);
    LAS int* YOFF = (LAS int*)(F.lds + TB_YOFF);
    const int gw = F.bid * NWAVES + F.wave, NGW = F.G * NWAVES;
    const int cb = 256 * (F.lane >> 4) + 32 * ((F.lane >> 2) & 3) + 8 * (F.lane & 3);
    typedef float f32x2v __attribute__((ext_vector_type(2)));
    f32x4 lng[2][2], lnb[2][2];
#pragma unroll
    for (int g = 0; g < 2; ++g)
#pragma unroll
        for (int h = 0; h < 2; ++h) { lng[g][h] = *(const f32x4*)(a.ln2_g + cb + 128 * g + 4 * h); lnb[g][h] = *(const f32x4*)(a.ln2_b + cb + 128 * g + 4 * h); }
    u32x4 sn[2][2]; f32x4 wn[2][2];
#define P11_PF(mm0) do { _Pragma("unroll") for (int t = 0; t < 2; ++t) { const int m_ = (mm0) + t * NGW; if (m_ < NTOK) { sn[t][0] = *(const u32x4*)(SLOT + (size_t)m_ * 8); sn[t][1] = *(const u32x4*)(SLOT + (size_t)m_ * 8 + 4); \
            wn[t][0] = *(const f32x4*)(WTOK + (size_t)m_ * 8); wn[t][1] = *(const f32x4*)(WTOK + (size_t)m_ * 8 + 4); } } } while (0)
    P11_PF(gw);
    for (int m0 = gw; m0 < NTOK; m0 += 2 * NGW) {
        u32x4 yv[2][9], xv[2][2]; float wk[2][9];
        u32x4 sc_[2][2]; f32x4 wc_[2][2];
#pragma unroll
        for (int t = 0; t < 2; ++t) { sc_[t][0] = sn[t][0]; sc_[t][1] = sn[t][1]; wc_[t][0] = wn[t][0]; wc_[t][1] = wn[t][1]; }
        P11_PF(m0 + 2 * NGW);
#pragma unroll
        for (int t = 0; t < 2; ++t) { const int m = m0 + t * NGW;
            const u32x4 s0 = sc_[t][0], s1 = sc_[t][1];
            const unsigned sl[8] = {s0.x, s0.y, s0.z, s0.w, s1.x, s1.y, s1.z, s1.w};
            const f32x4 w0 = wc_[t][0], w1 = wc_[t][1];
            wk[t][0] = w0.x; wk[t][1] = w0.y; wk[t][2] = w0.z; wk[t][3] = w0.w; wk[t][4] = w1.x; wk[t][5] = w1.y; wk[t][6] = w1.z; wk[t][7] = w1.w; wk[t][8] = 1.0f;
            yv[t][8] = *((const u32x4*)(YS + (size_t)(NTOK * 8 + m) * 1024) + F.lane);
#pragma unroll
            for (int k = 0; k < 8; ++k) { const int row = YOFF[sl[k] >> 16] + (int)(sl[k] & 0xffffu); yv[t][k] = *((const u32x4*)(YS + (size_t)row * 1024) + F.lane); }
            const bf16_t* xrow = (const bf16_t*)(a.out + (size_t)m * DM);
            xv[t][0] = *(const u32x4*)(xrow + cb); xv[t][1] = *(const u32x4*)(xrow + cb + 128); }
#pragma unroll
        for (int t = 0; t < 2; ++t) { const int m = m0 + t * NGW, b = m >> 11;
            float f[16];
#pragma unroll
            for (int i = 0; i < 16; ++i) f[i] = 0.f;
#pragma unroll
            for (int k = 8; k >= 0; --k)
#pragma unroll
                for (int d = 0; d < 4; ++d) { const f32x2v lo = __builtin_amdgcn_cvt_pk_f32_fp8((int)yv[t][k][d], false), hi = __builtin_amdgcn_cvt_pk_f32_fp8((int)yv[t][k][d], true);
                    f[4 * d] += wk[t][k] * lo.x; f[4 * d + 1] += wk[t][k] * lo.y; f[4 * d + 2] += wk[t][k] * hi.x; f[4 * d + 3] += wk[t][k] * hi.y; }
            const u32x4 xv0 = xv[t][0], xv1 = xv[t][1];
            float x1[16] = {bflo(xv0.x), bfhi(xv0.x), bflo(xv0.y), bfhi(xv0.y), bflo(xv0.z), bfhi(xv0.z), bflo(xv0.w), bfhi(xv0.w),
                            bflo(xv1.x), bfhi(xv1.x), bflo(xv1.y), bfhi(xv1.y), bflo(xv1.z), bfhi(xv1.z), bflo(xv1.w), bfhi(xv1.w)};
            float v[16]; float s = 0.f;
#pragma unroll
            for (int g = 0; g < 2; ++g)
#pragma unroll
                for (int h = 0; h < 2; ++h) { const f32x4 g2 = *(const f32x4*)(mod + b * 6144 + 5 * DM + cb + 128 * g + 4 * h);
#pragma unroll
                    for (int j = 0; j < 4; ++j) { const int i = 8 * g + 4 * h + j; v[i] = x1[i] * DN_ALPHA + g2[j] * (f[i] * pg8::YS_INV); s += v[i]; } }
            const float mean = wave_sum(s) * (1.f / DM); float s2 = 0.f;
#pragma unroll
            for (int i = 0; i < 16; ++i) { v[i] -= mean; s2 += v[i] * v[i]; }
            const float rstd = 1.f / sqrtf(wave_sum(s2) * (1.f / DM) + LN_EPS);
#pragma unroll
            for (int g = 0; g < 2; ++g)
#pragma unroll
                for (int h = 0; h < 2; ++h) { const int c = cb + 128 * g + 4 * h; const f32x4 gg = lng[g][h], be = lnb[g][h];
                    f32x4 o;
#pragma unroll
                    for (int j = 0; j < 4; ++j) o[j] = v[8 * g + 4 * h + j] * rstd * gg[j] + be[j];
                    *(f32x4*)(dst + (size_t)m * DM + c) = o; }
        }
    }
#undef P11_PF
}

#ifdef PROBE_SUB
__device__ __forceinline__ void p3_sub(Frame& F, const Args& a) {
    unsigned char* ws = a.ws;
    const int gw = F.bid * NWAVES + F.wave, NGW = F.G * NWAVES;
    if constexpr (PROBE_SUB == 1) { G1In R0, R1; int u = F.bid; if (u < 1024) g1_load(F, a, u, R0);
        for (; u < 1024; u += F.G) { const int un = u + F.G; if (un < 1024) g1_load(F, a, un, R1); gla_g1(F, a, u, R0); R0 = R1; } }
    if constexpr (PROBE_SUB == 2 || PROBE_SUB == 4) {
        int cit = gw; unsigned char* sbdummy = ws + WS_CTL + 524288 + (size_t)gw * 64;
        const int lw = (F.bid >> 3) * NWAVES + F.wave, bh = (F.bid & 7) * 8 + (lw >> 5), qb = lw & 31;
        sb_unit<PROBE_SUB == 4>(bh, qb, (const bf16_t*)(ws + WS_PROJ), (const bf16_t*)(ws + WS_VT), (bf16_t*)(ws + WS_OCAT), F.lane, a, cit, NGW, F.lds + F.wave * SB_LDS, sbdummy);
        sb_unit<PROBE_SUB == 4>(bh, 63 - qb, (const bf16_t*)(ws + WS_PROJ), (const bf16_t*)(ws + WS_VT), (bf16_t*)(ws + WS_OCAT), F.lane, a, cit, NGW, F.lds + F.wave * SB_LDS, sbdummy);
        if constexpr (PROBE_SUB == 4) { for (; cit < MOE_ITEMS; cit += NGW) { f32x4 cv[16]; moe_item_load(a, cit, F.lane, cv); moe_item_store(a, cit, F.lane, cv); } }
    }
    if constexpr (PROBE_SUB == 3) { for (int cit = gw; cit < MOE_ITEMS; cit += NGW) { f32x4 cv[16]; moe_item_load(a, cit, F.lane, cv); moe_item_store(a, cit, F.lane, cv); } }
}
#endif
template <int P> __device__ __forceinline__ void run_phase(Frame& F, const Args& a) {
    unsigned char* ws = a.ws;
    if constexpr (P == 0) { p0_phase(F, a); }
    if constexpr (P == 1) { p1_phase(F, a); }
    if constexpr (P == 2) {
        for (int t = F.bid * NWAVES + F.wave; t < NTOK / 16; t += F.G * NWAVES) glr_tile(F, a, t);
        __syncthreads();
        { pg8::Gemm g{(const bf16_t*)(ws + WS_H1), (const bf16_t*)(ws + WS_WIN), NTOK, PW, DM}; pg8::StaticOrder S; S.init(NTOK, PW, F.G, F.bid);
          pg8::EpiStore E{(bf16_t*)(ws + WS_PROJ), PW};
          pg8::gemm_phase<pg8::EpiStore, pg8::StaticOrder, true, pg8::NoGather>(F.lds, g, S, E, pg8::NoGather{}); }
        { pg8::Gemm g{(const bf16_t*)(ws + WS_WV), (const bf16_t*)(ws + WS_H1), 1024, NTOK, DM}; pg8::StaticOrder S; S.init(1024, NTOK, F.G, F.bid);
          pg8::EpiVT E{(bf16_t*)(ws + WS_VT)};
          pg8::gemm_phase<pg8::EpiVT, pg8::StaticOrder, true, pg8::NoGather>(F.lds, g, S, E, pg8::NoGather{}); }
    }
    if constexpr (P == 3) {
        const int gw = F.bid * NWAVES + F.wave, NGW = F.G * NWAVES;
        { G1In R0, R1; int u = F.bid; if (u < 1024) g1_load(F, a, u, R0);
          for (; u < 1024; u += F.G) { const int un = u + F.G; if (un < 1024) g1_load(F, a, un, R1); gla_g1(F, a, u, R0); R0 = R1; } }
        int cit = gw;
        unsigned char* sbdummy = ws + WS_CTL + 524288 + (size_t)gw * 64;
        if ((F.G & 7) == 0 && (F.G >> 3) * NWAVES * 2 * 8 == 4096) {
            const int lw = (F.bid >> 3) * NWAVES + F.wave, bh = (F.bid & 7) * 8 + (lw >> 5), qb = lw & 31;
            sb_unit(bh, qb, (const bf16_t*)(ws + WS_PROJ), (const bf16_t*)(ws + WS_VT), (bf16_t*)(ws + WS_OCAT), F.lane, a, cit, NGW, F.lds + F.wave * SB_LDS, sbdummy);
            sb_unit(bh, 63 - qb, (const bf16_t*)(ws + WS_PROJ), (const bf16_t*)(ws + WS_VT), (bf16_t*)(ws + WS_OCAT), F.lane, a, cit, NGW, F.lds + F.wave * SB_LDS, sbdummy);
        } else
        for (int u = gw; u < 2048; u += NGW) {
            sb_unit(u >> 6, u & 63, (const bf16_t*)(ws + WS_PROJ), (const bf16_t*)(ws + WS_VT), (bf16_t*)(ws + WS_OCAT), F.lane, a, cit, NGW, F.lds + F.wave * SB_LDS, sbdummy);
            const int u2 = 4095 - u;
            sb_unit(u2 >> 6, u2 & 63, (const bf16_t*)(ws + WS_PROJ), (const bf16_t*)(ws + WS_VT), (bf16_t*)(ws + WS_OCAT), F.lane, a, cit, NGW, F.lds + F.wave * SB_LDS, sbdummy);
        }
        for (; cit < MOE_ITEMS; cit += NGW) { f32x4 cv[16]; moe_item_load(a, cit, F.lane, cv); moe_item_store(a, cit, F.lane, cv); }
    }
    if constexpr (P == 4) { gla_scan(F, a); }
    if constexpr (P == 5) {
        G3In R0, R1;
        int u = F.bid; if (u < 1024) g3_load(F, a, u, R0);
        for (; u < 1024; u += F.G) { const int un = u + F.G; if (un < 1024) g3_load(F, a, un, R1); gla_g3(F, a, u, R0); R0 = R1; }
    }
    if constexpr (P == 6) {
        pg8::StaticOrder S; S.init(NTOK, DM, F.G, F.bid);
        pg8::Gemm g{(const bf16_t*)(ws + WS_OCAT), (const bf16_t*)(ws + WS_WCAT), NTOK, DM, DM}; pg8::EpiBranch E{(const bf16_t*)(ws + WS_PROJ), (bf16_t*)(ws + WS_Y)};
        pg8::gemm_phase<pg8::EpiBranch, pg8::StaticOrder, true, pg8::NoGather>(F.lds, g, S, E, pg8::NoGather{});
    }
    if constexpr (P == 7) {
        pg8::Gemm g{(const bf16_t*)(ws + WS_Y), (const bf16_t*)(ws + WS_WOUT), NTOK, DM, DM}; pg8::StaticOrder S; S.init(NTOK, DM, F.G, F.bid);
        pg8::EpiOut E{(const float*)(ws + WS_MOD), (bf16_t*)a.out};
        pg8::gemm_phase<pg8::EpiOut, pg8::StaticOrder, true, pg8::NoGather>(F.lds, g, S, E, pg8::NoGather{});
    }
    if constexpr (P == 8) { p8_phase(F, a); }
    if constexpr (P == 9) {
        const int ntiles = moe_tables(F, a);
        pg8::MoeTab tb{(const LAS int*)(F.lds + TB_TE), (const LAS int*)(F.lds + TB_TP), (const LAS int*)(F.lds + TB_CNT), (const LAS int*)(F.lds + TB_YOFF)};
        pg8::Gemm g{(const bf16_t*)(ws + WS_H2), (const bf16_t*)(ws + WS_WGU), NTOK, 512, DM / 2};
        pg8::MoeOrder S{ntiles * 2, 2, F.G, F.bid, tb.tile_e};
        pg8::EpiMoe1 E{ws + WS_ACT, 1.0f / (F8W_SCALE * F8H_SCALE)};
        pg8::MoeGather GA{tb, (const int*)(ws + WS_LIST)};
        pg8::gemm_phase<pg8::EpiMoe1, pg8::MoeOrder, true, pg8::MoeGather, true>(F.lds, g, S, E, GA);
    }
    if constexpr (P == 10) {
        const int ntiles = __builtin_amdgcn_readfirstlane(*(const LAS int*)(F.lds + TB_NT));
        pg8::MoeTab tb{(const LAS int*)(F.lds + TB_TE), (const LAS int*)(F.lds + TB_TP), (const LAS int*)(F.lds + TB_CNT), (const LAS int*)(F.lds + TB_YOFF)};
        pg8::Gemm g{(const bf16_t*)(ws + WS_ACT), (const bf16_t*)(ws + WS_WDN), NTOK, DM, 256 / 2};
        pg8::MoeOrder S{ntiles * 4, 4, F.G, F.bid, tb.tile_e};
        pg8::EpiMoe2 E{tb, ws + WS_YS, pg8::YS_SCALE / (F8W_SCALE * F8A_SCALE)};
        pg8::gemm_phase<pg8::EpiMoe2, pg8::MoeOrder, true, pg8::NoGather, true>(F.lds, g, S, E, pg8::NoGather{});
    }
    if constexpr (P == 11) { p11_phase(F, a, a.out); }
}
#define MK_FRAME() Frame F; { int t_ = threadIdx.x; asm volatile("" : "+v"(t_)); F.lds = (LAS unsigned char*)lds_raw; F.tid = t_; F.lane = t_ & 63; F.wave = __builtin_amdgcn_readfirstlane(t_ >> 6); F.G = gridDim.x; F.bid = blockIdx.x; }

extern __shared__ __attribute__((aligned(16))) unsigned char lds_raw[];
template <int P> __global__ void __launch_bounds__(NTHR, 2) fwd_ph(Args a) { MK_FRAME(); run_phase<P>(F, a); }

#ifndef N_LAUNCHES
#define N_LAUNCHES 1
#endif
#if N_LAUNCHES == 1
__global__ void __launch_bounds__(NTHR, 2) fwd_all(Args a_unused) {
    volatile LAS unsigned* bst = (volatile LAS unsigned*)((LAS unsigned char*)lds_raw + LDS_BYTES - 64);
    if (threadIdx.x < 2) bst[threadIdx.x] = 0u;
    __syncthreads();
    XcdBarrier bar;
    { auto kp0 = __builtin_amdgcn_kernarg_segment_ptr(); bar = xcd_barrier_post((unsigned*)(((const Args*)kp0)->ws + WS_CTL) + CW_BAR, bst); }
#define PH(k) { MK_FRAME(); auto kp_ = __builtin_amdgcn_kernarg_segment_ptr(); asm volatile("" : "+s"(kp_)); run_phase<k>(F, *(const Args*)kp_); }
    PH(0) xcd_barrier(bar);
    PH(1) xcd_barrier(bar); PH(2) xcd_barrier(bar); PH(3) xcd_barrier(bar);
#ifdef PROBE_SUB
    { MK_FRAME(); auto kp_ = __builtin_amdgcn_kernarg_segment_ptr(); asm volatile("" : "+s"(kp_)); p3_sub(F, *(const Args*)kp_); } xcd_barrier(bar);
#endif
    PH(4) xcd_barrier(bar); PH(5) xcd_barrier(bar);
    PH(6) xcd_barrier(bar); PH(7) xcd_barrier(bar); PH(8) xcd_barrier(bar); PH(9) xcd_barrier(bar); PH(10) xcd_barrier(bar); PH(11)
#undef PH
}
#endif

template <int P> static void launch_ph(int grid, const Args& a, hipStream_t stream) {
    static bool attr = false;
    if (!attr) { (void)hipFuncSetAttribute((const void*)fwd_ph<P>, hipFuncAttributeMaxDynamicSharedMemorySize, LDS_BYTES); attr = true; }
    hipLaunchKernelGGL(fwd_ph<P>, dim3(grid), dim3(NTHR), LDS_BYTES, stream, a);
}
extern "C" void kernel_launch(void* const* d_in, const int* in_sizes, int n_in, void* d_out, int out_size, void* d_ws, size_t ws_size, hipStream_t stream) {
    static int grid = 0;
    if (grid == 0) {
        if (n_in != 21 || out_size != NTOK * DM || ws_size < WS_END) { fprintf(stderr, "kernel_launch: unexpected shapes (n_in %d out %d ws %zu)\n", n_in, out_size, ws_size); grid = -1; return; }
        int dev = 0, cus = 0, per_cu = 0;
        (void)hipGetDevice(&dev); (void)hipDeviceGetAttribute(&cus, hipDeviceAttributeMultiprocessorCount, dev);
#if N_LAUNCHES == 1
        if (hipFuncSetAttribute((const void*)fwd_all, hipFuncAttributeMaxDynamicSharedMemorySize, LDS_BYTES) != hipSuccess) { fprintf(stderr, "kernel_launch: hipFuncSetAttribute failed\n"); grid = -1; return; }
        (void)hipOccupancyMaxActiveBlocksPerMultiprocessor(&per_cu, (const void*)fwd_all, NTHR, LDS_BYTES);
#else
        per_cu = 1;
#endif
        (void)hipGetLastError();
        if (per_cu < 1) { fprintf(stderr, "kernel_launch: occupancy query reports %d blocks per CU\n", per_cu); per_cu = 1; }
        grid = cus;
        fprintf(stderr, "kernel_launch: cus %d per_cu %d grid %d\n", cus, per_cu, grid);
    }
    if (grid < 0) return;
    (void)hipMemsetAsync((char*)d_ws + WS_CTL, 0, CTL_ZERO_BYTES, stream);
    Args a{};
    const float** ap = (const float**)&a;
    for (int i = 0; i < 21; ++i) ap[i] = (const float*)d_in[i];
    a.out = (float*)d_out; a.ws = (unsigned char*)d_ws;
#if N_LAUNCHES == 1
    {
        void* args[] = {&a};
        hipError_t e = hipLaunchCooperativeKernel((const void*)fwd_all, dim3(grid), dim3(NTHR), args, LDS_BYTES, stream);
        if (e != hipSuccess) fprintf(stderr, "kernel_launch: cooperative launch failed: %s\n", hipGetErrorString(e));
    }
#else
    {
        launch_ph<0>(grid, a, stream); launch_ph<1>(grid, a, stream); launch_ph<2>(grid, a, stream); launch_ph<3>(grid, a, stream);
        launch_ph<4>(grid, a, stream); launch_ph<5>(grid, a, stream); launch_ph<6>(grid, a, stream); launch_ph<7>(grid, a, stream);
        launch_ph<8>(grid, a, stream); launch_ph<9>(grid, a, stream); launch_ph<10>(grid, a, stream); launch_ph<11>(grid, a, stream);
    }
#endif
}
```

```cpp
#include <hip/hip_runtime.h>
#include <hip/hip_cooperative_groups.h>
#include <cstdio>
#include <cstdint>
namespace cg = cooperative_groups;

#define LAS __attribute__((address_space(3)))
#define GAS __attribute__((address_space(1)))
typedef unsigned short bf16_t;
typedef short bf16x8 __attribute__((ext_vector_type(8)));
typedef short bf16x4 __attribute__((ext_vector_type(4)));
typedef float f32x4 __attribute__((ext_vector_type(4)));
typedef float f32x16 __attribute__((ext_vector_type(16)));
typedef unsigned u32x4 __attribute__((ext_vector_type(4)));
typedef unsigned u32x2 __attribute__((ext_vector_type(2)));
typedef int i32x8 __attribute__((ext_vector_type(8))); typedef int i32x4 __attribute__((ext_vector_type(4)));

#define LDS_WAIT() asm volatile("s_waitcnt lgkmcnt(0)" ::: "memory")
#define VM_WAIT() asm volatile("s_waitcnt vmcnt(0)" ::: "memory")

__device__ __forceinline__ unsigned f2bf(float f) { unsigned u = __builtin_bit_cast(unsigned, f); return (u + 0x7fffu + ((u >> 16) & 1u)) >> 16; }
typedef float f32x2_t __attribute__((ext_vector_type(2))); typedef __bf16 bf16x2_t __attribute__((ext_vector_type(2)));
__device__ __forceinline__ unsigned pk2(float lo, float hi) { f32x2_t v = {lo, hi}; bf16x2_t b = __builtin_convertvector(v, bf16x2_t); return __builtin_bit_cast(unsigned, b); }
__device__ __forceinline__ float bf2f(unsigned short b) { return __builtin_bit_cast(float, (unsigned)b << 16); }
__device__ __forceinline__ float bflo(unsigned w) { return __builtin_bit_cast(float, w << 16); }
__device__ __forceinline__ float bfhi(unsigned w) { return __builtin_bit_cast(float, w & 0xffff0000u); }
__device__ __forceinline__ float fexp(float x) { return __builtin_amdgcn_exp2f(x * 1.4426950408889634f); }
__device__ __forceinline__ float flog(float x) { return __builtin_amdgcn_logf(x) * 0.6931471805599453f; }
__device__ __forceinline__ float sigmoidf_(float x) { return __builtin_amdgcn_rcpf(1.0f + fexp(-x)); }
__device__ __forceinline__ float logsigmoid_(float x) { return fminf(x, 0.f) - flog(1.0f + fexp(-fabsf(x))); }
template <int CTRL> __device__ __forceinline__ float dppf(float v) { return __builtin_bit_cast(float, __builtin_amdgcn_update_dpp(0, __builtin_bit_cast(int, v), CTRL, 0xF, 0xF, true)); }
template <int CTRL> __device__ __forceinline__ int dppi(int v) { return __builtin_amdgcn_update_dpp(0, v, CTRL, 0xF, 0xF, true); }
template <int L> __device__ __forceinline__ float rlane(float v) { return __builtin_bit_cast(float, __builtin_amdgcn_readlane(__builtin_bit_cast(int, v), L)); }
__device__ __forceinline__ float row16_sum(float v) { v += dppf<0xB1>(v); v += dppf<0x4E>(v); v += dppf<0x141>(v); v += dppf<0x140>(v); return v; }
__device__ __forceinline__ float grp8_max(float v) { v = fmaxf(v, dppf<0xB1>(v)); v = fmaxf(v, dppf<0x4E>(v)); v = fmaxf(v, dppf<0x141>(v)); return v; }
__device__ __forceinline__ int grp8_min(int v) { v = min(v, dppi<0xB1>(v)); v = min(v, dppi<0x4E>(v)); v = min(v, dppi<0x141>(v)); return v; }
__device__ __forceinline__ float wave_max(float v) {
    v = fmaxf(v, dppf<0xB1>(v)); v = fmaxf(v, dppf<0x4E>(v)); v = fmaxf(v, dppf<0x141>(v)); v = fmaxf(v, dppf<0x140>(v));
    return fmaxf(fmaxf(rlane<0>(v), rlane<16>(v)), fmaxf(rlane<32>(v), rlane<48>(v)));
}
__device__ __forceinline__ float wave_sum(float v) {
    v = row16_sum(v);
    return (rlane<0>(v) + rlane<16>(v)) + (rlane<32>(v) + rlane<48>(v));
}

constexpr int NTOK = 16384, DM = 1024, SEQ = 2048, NB = 8;
constexpr int PW = 4096;
constexpr int C_QSB = 0, C_KSB = 512, C_QG = 1024, C_KG = 1280, C_RG = 1536, C_MG = 2048;
constexpr int NEXP = 64, ECAP = 16384;
constexpr float LN_EPS = 1e-5f;
constexpr float DN_ALPHA = 1.189207115002721f;
constexpr float ROUTED_SCALE = 2.5f;

constexpr size_t MiB = 1u << 20;
constexpr size_t WS_CTL = 0, CTL_ZERO_BYTES = 1 * MiB;
constexpr size_t WS_MOD = 1 * MiB;
constexpr size_t WS_GLR = 2 * MiB;
constexpr size_t WS_DEC = 3 * MiB;
constexpr size_t WS_SLOT = 4 * MiB;
constexpr size_t WS_LIST = 6 * MiB;
constexpr size_t WS_GWT = 10 * MiB;
constexpr size_t WS_WSM = 14 * MiB;
constexpr size_t WS_WCAT = 15 * MiB, WS_WOUT = 17 * MiB;
constexpr size_t WS_WIN = 19 * MiB;
constexpr size_t WS_WV = 27 * MiB;
constexpr size_t WS_WDN = 29 * MiB;
constexpr size_t WS_WGU = 62 * MiB;
constexpr size_t WS_H1 = 127 * MiB;
constexpr size_t WS_PROJ = 159 * MiB;
constexpr size_t WS_VT = 319 * MiB;
constexpr size_t WS_OCAT = 351 * MiB;
constexpr size_t WS_Y = 383 * MiB;
constexpr size_t WS_KVT = 415 * MiB;
constexpr size_t WS_ST16 = 447 * MiB;
constexpr size_t WS_H2 = 463 * MiB;
constexpr size_t WS_ACT = 127 * MiB;
constexpr size_t WS_YS = 207 * MiB;
constexpr size_t WS_END = 495 * MiB;
constexpr int CW_BAR = 4096;
constexpr int CW_CNT = 8192;

namespace pg8 {
constexpr int BM = 256, BK = 64, HALF = 128, HTB = HALF * BK * 2, STAGE_BYTES = 8 * HTB, NXCD = 8, WGM = 8;
__host__ __device__ __forceinline__ int lds_byte(int r, int c) { const int st = (r >> 4) * 2 + (c >> 5), rr = r & 15, cc = c & 31, ob = rr * 64 + cc * 2; return st * 1024 + (ob ^ (((ob >> 9) & 1) << 5)); }
__host__ __device__ __forceinline__ void stage_rc(int b, int& R, int& C) { const int st = b / 1024, sb = b % 1024, swz = sb ^ (((sb >> 9) & 1) << 5); R = (st >> 1) * 16 + swz / 64; C = (st & 1) * 32 + (swz % 64) / 2; }
__host__ __device__ __forceinline__ int perm32(int rho) { const int n = rho >> 4, i = rho & 15; return 8 * (i >> 2) + 4 * n + (i & 3); }

struct Unit { int pm, pn; };
struct Gemm { const bf16_t* A; const bf16_t* Bt; int M, N, K; };

struct StaticOrder {
    int nM, nN, nwg, G, c;
    __host__ __device__ void init(int M, int N, int G_, int c_) { nM = M / BM; nN = N / BM; nwg = nM * nN; G = G_; c = c_; }
    __host__ __device__ bool next(int i, Unit& u) const {
        const long L = (long)i * G + c; if (L >= nwg) return false;
        int wgid = (int)L; { const int q = nwg / NXCD, r = nwg % NXCD, xcd = wgid % NXCD, off = wgid / NXCD; wgid = (xcd < r ? xcd * (q + 1) : r * (q + 1) + (xcd - r) * q) + off; }
        const int nig = WGM * nN, gid = wgid / nig, fm = gid * WGM, gsz = (nM - fm) < WGM ? (nM - fm) : WGM;
        u.pm = fm + ((wgid % nig) % gsz); u.pn = (wgid % nig) / gsz; return true;
    }
};
struct MoeOrder {
    int nunits, nN, G, c; const LAS int* tile_e;
    __device__ __forceinline__ bool next(int i, Unit& u) const {
        const int v = ((G & 7) == 0) ? (c & 7) * (G >> 3) + (c >> 3) : c;
        const long L = (long)i * G + v; if (L >= nunits) return false;
        const int tile = (int)L / nN, pnl = (int)L % nN;
        const int e = __builtin_amdgcn_readfirstlane(tile_e[tile]);
        u.pm = tile; u.pn = e * nN + pnl; return true;
    }
};
struct NoGather { static constexpr bool ON = false; __device__ __forceinline__ unsigned row(const Unit&, int) const { return 0u; } };

template <class Epi, class Sched, bool ALIGN_EPI, class Gath, bool F8 = false>
__device__ __forceinline__ void gemm_phase(LAS unsigned char* lds, const Gemm g, const Sched& S, const Epi& E, const Gath& GA) {
    int tid_ = threadIdx.x; asm volatile("" : "+v"(tid_));
    const int tid = tid_, wid = __builtin_amdgcn_readfirstlane(tid >> 6), lane = tid & 63, wr = wid >> 2, wc = wid & 3, fr = lane & 15, fq = lane >> 4;
    const int K = g.K, nt = K / BK;
    unsigned voffA[2], voffB[2]; int RA[2], CA2[2];
#pragma unroll
    for (int i = 0; i < 2; ++i) { int R, C; stage_rc(tid * 16 + i * 8192, R, C); const int Rb = Epi::PERM ? ((R & ~31) + perm32(R & 31)) : R;
        voffA[i] = (unsigned)(R * K + C) * 2u; voffB[i] = (unsigned)(Rb * K + C) * 2u; RA[i] = R; CA2[i] = C * 2; }
    const size_t kstep = (size_t)(BK * 2);
    const size_t hstep = (size_t)HALF * K * 2;
    const size_t tstep = 2 * hstep;
    const size_t hstepA = Gath::ON ? 0 : hstep;
    const unsigned ldsw = (unsigned)wid * 1024u;
    const int aoff = lds_byte(wr * 64 + fr, fq * 8), boff = lds_byte(wc * 32 + fr, fq * 8);
#define PG8_SA(b, h) (((b) * 2 + (h)) * HTB)
#define PG8_SB(b, h) ((4 + (b) * 2 + (h)) * HTB)
#define PG8_STAGE(bufoff, gbase, voff) do { _Pragma("unroll") for (int _i = 0; _i < 2; ++_i) \
        __builtin_amdgcn_global_load_lds((const unsigned*)((const char*)(gbase) + (voff)[_i]), (LAS unsigned*)(lds + (bufoff) + ldsw + _i * 8192), 16, 0, 0); } while (0)
#define PG8_STAGE_A(bufoff, gbase, h, usenext) do { if constexpr (Gath::ON) { unsigned _o[2]; _o[0] = (usenext) ? gan[h][0] : gac[h][0]; _o[1] = (usenext) ? gan[h][1] : gac[h][1]; PG8_STAGE(bufoff, gbase, _o); } \
        else { PG8_STAGE(bufoff, (gbase) + (h) * hstepA, voffA); } } while (0)
#define PG8_LDA(dst, b, h) do { _Pragma("unroll") for (int m = 0; m < 4; ++m) _Pragma("unroll") for (int k = 0; k < 2; ++k) dst[m].q[k] = *(const LAS bf16x8*)(lds + PG8_SA(b, h) + aoff + m * 2048 + k * 1024); } while (0)
#define PG8_LDB(dst, b, h) do { _Pragma("unroll") for (int n = 0; n < 2; ++n) _Pragma("unroll") for (int k = 0; k < 2; ++k) dst[n].q[k] = *(const LAS bf16x8*)(lds + PG8_SB(b, h) + boff + n * 2048 + k * 1024); } while (0)
#define PG8_MMA(ai, bj, At, Bt) do { __builtin_amdgcn_s_setprio(1); \
        if constexpr (F8) { _Pragma("unroll") for (int m = 0; m < 4; ++m) _Pragma("unroll") for (int n = 0; n < 2; ++n) \
            asm volatile("v_mfma_f32_16x16x128_f8f6f4 %0, %1, %2, %0" : "+v"(acc[ai][bj][m][n]) : "v"(Bt[n].w), "v"(At[m].w)); } \
        else { _Pragma("unroll") for (int m = 0; m < 4; ++m) _Pragma("unroll") for (int n = 0; n < 2; ++n) _Pragma("unroll") for (int k = 0; k < 2; ++k) \
            acc[ai][bj][m][n] = __builtin_amdgcn_mfma_f32_16x16x32_bf16(Bt[n].q[k], At[m].q[k], acc[ai][bj][m][n], 0, 0, 0); } \
        __builtin_amdgcn_s_setprio(0); } while (0)
#define PG8_WAIT_V(n) asm volatile("s_waitcnt vmcnt(" #n ")" ::: "memory")
#define PG8_WAIT_L(n) asm volatile("s_waitcnt lgkmcnt(" #n ")" ::: "memory")
#define PG8_BAR __builtin_amdgcn_s_barrier()
#define PG8_SCHED __builtin_amdgcn_sched_barrier(0)
    Unit cur, nxt; int ui = 0;
    if (!S.next(0, cur)) return;
    f32x4 acc[2][2][4][2];
#pragma unroll
    for (int a = 0; a < 2; ++a)
#pragma unroll
        for (int b = 0; b < 2; ++b)
#pragma unroll
            for (int m = 0; m < 4; ++m)
#pragma unroll
                for (int n = 0; n < 2; ++n) acc[a][b][m][n] = (f32x4){0.f, 0.f, 0.f, 0.f};
    union Frag { bf16x8 q[2]; i32x8 w; }; Frag At[4], B0[2], B1[2];
    unsigned gac[2][2], gan[2][2];
    if constexpr (Gath::ON) {
#pragma unroll
        for (int h = 0; h < 2; ++h)
#pragma unroll
            for (int i = 0; i < 2; ++i) { gac[h][i] = GA.row(cur, h * HALF + RA[i]) * (unsigned)(K * 2) + (unsigned)CA2[i]; gan[h][i] = gac[h][i]; }
    }
    const char* cA = (const char*)g.A + (Gath::ON ? (size_t)0 : (size_t)cur.pm * tstep); const char* cB = (const char*)g.Bt + (size_t)cur.pn * tstep;
    PG8_STAGE(PG8_SB(0, 0), cB, voffB); PG8_STAGE(PG8_SB(0, 1), cB + hstep, voffB); PG8_STAGE_A(PG8_SA(0, 0), cA, 0, false); PG8_STAGE_A(PG8_SA(0, 1), cA, 1, false);
    if (wr == 1) PG8_BAR;
    PG8_WAIT_V(2); PG8_BAR;
    PG8_STAGE(PG8_SB(1, 0), cB + kstep, voffB); PG8_STAGE_A(PG8_SA(1, 0), cA + kstep, 0, false); PG8_STAGE(PG8_SB(1, 1), cB + hstep + kstep, voffB);
    PG8_WAIT_V(6); PG8_BAR;
    for (;;) {
        const bool has_next = S.next(ui + 1, nxt);
        const char* nA = (has_next && !Gath::ON) ? (const char*)g.A + (size_t)nxt.pm * tstep : cA; const char* nB = has_next ? (const char*)g.Bt + (size_t)nxt.pn * tstep : cB;
        if constexpr (Gath::ON) {
            if (has_next) {
#pragma unroll
                for (int h = 0; h < 2; ++h)
#pragma unroll
                    for (int i = 0; i < 2; ++i) gan[h][i] = GA.row(nxt, h * HALF + RA[i]) * (unsigned)(K * 2) + (unsigned)CA2[i];
            }
        }
#pragma unroll 1
        for (int t = 0; t < nt; t += 2) {
            const bool last = (t == nt - 2);
            if constexpr (Epi::MIDK) { if (t == nt / 2) E.mid(acc, cur, wr, wc, fr, fq); }
            const char* a1 = cA + (size_t)(t + 1) * kstep;
            const char* a2 = last ? nA : cA + (size_t)(t + 2) * kstep; const char* b2 = last ? nB : cB + (size_t)(t + 2) * kstep;
            const char* a3 = a2 + kstep; const char* b3 = b2 + kstep;
            PG8_LDB(B0, 0, 0); PG8_LDB(B1, 0, 1); PG8_SCHED; PG8_LDA(At, 0, 0); PG8_STAGE_A(PG8_SA(1, 1), a1, 1, false);
            PG8_WAIT_V(8); PG8_WAIT_L(0); PG8_BAR; PG8_MMA(0, 0, At, B0); PG8_MMA(0, 1, At, B1); PG8_BAR; PG8_SCHED;
            PG8_LDA(At, 0, 1); PG8_STAGE(PG8_SB(0, 0), b2, voffB); PG8_STAGE(PG8_SB(0, 1), b2 + hstep, voffB); PG8_STAGE_A(PG8_SA(0, 0), a2, 0, last);
            PG8_WAIT_V(8); PG8_WAIT_L(0); PG8_BAR; PG8_MMA(1, 0, At, B0); PG8_MMA(1, 1, At, B1); PG8_BAR; PG8_SCHED;
            PG8_LDB(B0, 1, 0); PG8_LDB(B1, 1, 1); PG8_SCHED; PG8_LDA(At, 1, 0); PG8_STAGE_A(PG8_SA(0, 1), a2, 1, last);
            PG8_WAIT_V(8); PG8_WAIT_L(0); PG8_BAR; PG8_MMA(0, 0, At, B0); PG8_MMA(0, 1, At, B1); PG8_BAR; PG8_SCHED;
            PG8_LDA(At, 1, 1); PG8_STAGE(PG8_SB(1, 0), b3, voffB); PG8_STAGE(PG8_SB(1, 1), b3 + hstep, voffB); PG8_STAGE_A(PG8_SA(1, 0), a3, 0, last);
            PG8_WAIT_V(8); PG8_WAIT_L(0); PG8_BAR; PG8_MMA(1, 0, At, B0); PG8_MMA(1, 1, At, B1); PG8_BAR; PG8_SCHED;
        }
        if constexpr (F8) { PG8_SCHED; asm volatile("s_nop 15\n\ts_nop 15" ::: "memory"); PG8_SCHED; }
        if constexpr (ALIGN_EPI) { if (wr == 0) PG8_BAR; }
        E(acc, cur, wr, wc, fr, fq);
        if (!has_next) break;
#pragma unroll
        for (int a = 0; a < 2; ++a)
#pragma unroll
            for (int b = 0; b < 2; ++b)
#pragma unroll
                for (int m = 0; m < 4; ++m)
#pragma unroll
                    for (int n = 0; n < 2; ++n) acc[a][b][m][n] = (f32x4){0.f, 0.f, 0.f, 0.f};
        cur = nxt; cA = nA; cB = nB; ++ui;
        if constexpr (Gath::ON) {
#pragma unroll
            for (int h = 0; h < 2; ++h)
#pragma unroll
                for (int i = 0; i < 2; ++i) gac[h][i] = gan[h][i];
        }
        if constexpr (ALIGN_EPI) { if (wr == 1) PG8_BAR; }
    }
    PG8_WAIT_V(0);
    if constexpr (!ALIGN_EPI) { if (wr == 0) PG8_BAR; }
    PG8_BAR;
#undef PG8_SA
#undef PG8_SB
#undef PG8_STAGE
#undef PG8_STAGE_A
#undef PG8_LDA
#undef PG8_LDB
#undef PG8_MMA
#undef PG8_WAIT_V
#undef PG8_WAIT_L
#undef PG8_BAR
#undef PG8_SCHED
}
}
constexpr float F8W_SCALE = 256.f, F8H_SCALE = 8.f, F8A_SCALE = 8.f;
__device__ __forceinline__ unsigned pack4_e4m3(float x0, float x1, float x2, float x3, float sc) {
    const float inv = __builtin_amdgcn_rcpf(sc), lim = 440.f * inv;
    const float c0 = __builtin_amdgcn_fmed3f(x0, -lim, lim), c1 = __builtin_amdgcn_fmed3f(x1, -lim, lim), c2 = __builtin_amdgcn_fmed3f(x2, -lim, lim), c3 = __builtin_amdgcn_fmed3f(x3, -lim, lim);
    typedef short s16x2_ __attribute__((ext_vector_type(2))); s16x2_ r = __builtin_bit_cast(s16x2_, c0);
    r = __builtin_amdgcn_cvt_scalef32_pk_fp8_f32(r, c0, c1, inv, false); r = __builtin_amdgcn_cvt_scalef32_pk_fp8_f32(r, c2, c3, inv, true); return __builtin_bit_cast(unsigned, r); }
namespace pg8 {
typedef const f32x4 (&AccRef)[2][2][4][2];

__device__ __forceinline__ unsigned gate_block_off(int gate, int pm, int pn, int blk, int wave) {
    const unsigned B0 = (unsigned)(((gate * 64 + pm) * 4 + pn) * 16 * 8 + wave);
    return (B0 >> 2) * (unsigned)(PW * 2) + (unsigned)PW + (B0 & 3u) * 1024u + (unsigned)blk * 16384u;
}
struct EpiStore {
    static constexpr bool PERM = true; static constexpr bool MIDK = false;
    bf16_t* o; int ldc; bool lanegates;
    __device__ __forceinline__ void operator()(AccRef acc, const Unit& u, int wr, int wc, int fr, int fq) const {
        const int row0 = u.pm * BM + wr * 64 + fr, col0 = u.pn * BM + wc * 32 + 8 * fq;
        const bool gt = lanegates && u.pn >= 8; const int gate = (u.pn - 8) >> 2, gpn = (u.pn - 8) & 3, lane16 = (fr + 16 * fq) * 16;
#pragma unroll
        for (int ai = 0; ai < 2; ++ai)
#pragma unroll
            for (int m = 0; m < 4; ++m) { bf16_t* rowp = o + (unsigned)((row0 + ai * HALF + m * 16) * ldc + col0);
#pragma unroll
                for (int bj = 0; bj < 2; ++bj) { const f32x4 v0 = acc[ai][bj][m][0], v1 = acc[ai][bj][m][1];
                    u32x4 w; w.x = pk2(v0[0], v0[1]); w.y = pk2(v0[2], v0[3]); w.z = pk2(v1[0], v1[1]); w.w = pk2(v1[2], v1[3]);
                    u32x4* dp = gt ? (u32x4*)((unsigned char*)o + gate_block_off(gate, u.pm, gpn, (ai * 4 + m) * 2 + bj, __builtin_amdgcn_readfirstlane(wr * 4 + wc)) + lane16) : (u32x4*)(rowp + bj * HALF);
                    __builtin_nontemporal_store(w, dp); } }
    }
};
struct EpiVT {
    static constexpr bool PERM = true; static constexpr bool MIDK = false;
    bf16_t* vt;
    __device__ __forceinline__ void operator()(AccRef acc, const Unit& u, int wr, int wc, int fr, int fq) const {
        const int row0 = u.pm * BM + wr * 64 + fr, b = u.pn >> 3, t0 = (u.pn & 7) * BM + wc * 32 + 8 * fq;
#pragma unroll
        for (int ai = 0; ai < 2; ++ai)
#pragma unroll
            for (int m = 0; m < 4; ++m) { bf16_t* rowp = vt + (unsigned)((b * 1024 + row0 + ai * HALF + m * 16) * SEQ + t0);
#pragma unroll
                for (int bj = 0; bj < 2; ++bj) { const f32x4 v0 = acc[ai][bj][m][0], v1 = acc[ai][bj][m][1];
                    u32x4 w; w.x = pk2(v0[0], v0[1]); w.y = pk2(v0[2], v0[3]); w.z = pk2(v1[0], v1[1]); w.w = pk2(v1[2], v1[3]);
                    __builtin_nontemporal_store(w, (u32x4*)(rowp + bj * HALF)); } }
    }
};

typedef f32x4 (&AccRefW)[2][2][4][2];
struct EpiBranch {
    static constexpr bool PERM = true; static constexpr bool MIDK = true;
    const bf16_t* proj; bf16_t* y;
    __device__ __forceinline__ void mid(AccRefW acc, const Unit& u, int wr, int wc, int fr, int fq) const {
        const int row0 = u.pm * BM + wr * 64 + fr, col0 = u.pn * BM + wc * 32 + 8 * fq;
#pragma unroll
        for (int ai = 0; ai < 2; ++ai)
#pragma unroll
            for (int m = 0; m < 4; ++m) {
#pragma unroll
                for (int bj = 0; bj < 2; ++bj) { const int blk = (ai * 4 + m) * 2 + bj, lane16 = (fr + 16 * fq) * 16;
                    const u32x4 ms = *(const u32x4*)((const unsigned char*)proj + gate_block_off(0, u.pm, u.pn, blk, __builtin_amdgcn_readfirstlane(wr * 4 + wc)) + lane16), mg = *(const u32x4*)((const unsigned char*)proj + gate_block_off(1, u.pm, u.pn, blk, __builtin_amdgcn_readfirstlane(wr * 4 + wc)) + lane16);
                    const unsigned msw[4] = {ms.x, ms.y, ms.z, ms.w}, mgw[4] = {mg.x, mg.y, mg.z, mg.w};
#pragma unroll
                    for (int k = 0; k < 4; ++k) {
                        const float r0 = (1.0f + fexp(fminf(-bflo(mgw[k]), 80.f))) * __builtin_amdgcn_rcpf(1.0f + fexp(fminf(-bflo(msw[k]), 80.f)));
                        const float r1 = (1.0f + fexp(fminf(-bfhi(mgw[k]), 80.f))) * __builtin_amdgcn_rcpf(1.0f + fexp(fminf(-bfhi(msw[k]), 80.f)));
                        acc[ai][bj][m][k >> 1][(k & 1) * 2] *= r0; acc[ai][bj][m][k >> 1][(k & 1) * 2 + 1] *= r1; } } }
    }
    __device__ __forceinline__ void operator()(AccRef acc, const Unit& u, int wr, int wc, int fr, int fq) const {
        const int row0 = u.pm * BM + wr * 64 + fr, col0 = u.pn * BM + wc * 32 + 8 * fq;
#pragma unroll
        for (int ai = 0; ai < 2; ++ai)
#pragma unroll
            for (int m = 0; m < 4; ++m) { const unsigned row = (unsigned)(row0 + ai * HALF + m * 16);
#pragma unroll
                for (int bj = 0; bj < 2; ++bj) {
                    const int col = col0 + bj * HALF;
                    const u32x4 g = *(const u32x4*)((const unsigned char*)proj + gate_block_off(1, u.pm, u.pn, (ai * 4 + m) * 2 + bj, __builtin_amdgcn_readfirstlane(wr * 4 + wc)) + (fr + 16 * fq) * 16);
                    const f32x4 v0 = acc[ai][bj][m][0], v1 = acc[ai][bj][m][1];
                    float o[8];
                    o[0] = sigmoidf_(bflo(g.x)) * v0[0]; o[1] = sigmoidf_(bfhi(g.x)) * v0[1]; o[2] = sigmoidf_(bflo(g.y)) * v0[2]; o[3] = sigmoidf_(bfhi(g.y)) * v0[3];
                    o[4] = sigmoidf_(bflo(g.z)) * v1[0]; o[5] = sigmoidf_(bfhi(g.z)) * v1[1]; o[6] = sigmoidf_(bflo(g.w)) * v1[2]; o[7] = sigmoidf_(bfhi(g.w)) * v1[3];
                    u32x4 w; w.x = pk2(o[0], o[1]); w.y = pk2(o[2], o[3]); w.z = pk2(o[4], o[5]); w.w = pk2(o[6], o[7]);
                    *(u32x4*)(y + row * DM + col) = w; } }
    }
};

struct EpiOut {
    static constexpr bool PERM = true; static constexpr bool MIDK = false;
    const float* mod; bf16_t* g1m;
    __device__ __forceinline__ void operator()(AccRef acc, const Unit& u, int wr, int wc, int fr, int fq) const {
        const int row0 = u.pm * BM + wr * 64 + fr, col0 = u.pn * BM + wc * 32 + 8 * fq;
        const int b = (u.pm * BM) >> 11;
        f32x4 gv[2][2];
#pragma unroll
        for (int bj = 0; bj < 2; ++bj)
#pragma unroll
            for (int n = 0; n < 2; ++n) gv[bj][n] = *(const f32x4*)(mod + b * 6144 + 2 * DM + col0 + bj * HALF + 4 * n);
#pragma unroll
        for (int ai = 0; ai < 2; ++ai)
#pragma unroll
            for (int m = 0; m < 4; ++m) { bf16_t* rowp = g1m + (unsigned)((row0 + ai * HALF + m * 16) * (2 * DM) + col0);
#pragma unroll
                for (int bj = 0; bj < 2; ++bj) { const f32x4 v0 = acc[ai][bj][m][0] * gv[bj][0], v1 = acc[ai][bj][m][1] * gv[bj][1];
                    u32x4 w; w.x = pk2(v0[0], v0[1]); w.y = pk2(v0[2], v0[3]); w.z = pk2(v1[0], v1[1]); w.w = pk2(v1[2], v1[3]);
                    *(u32x4*)(rowp + bj * HALF) = w; } }
    }
};

struct MoeTab { const LAS int* tile_e; const LAS int* tile_p0; const LAS int* cnt; const LAS int* yoff; };

struct MoeGather {
    static constexpr bool ON = true;
    MoeTab tb; const int* list;
    __device__ __forceinline__ unsigned row(const Unit& u, int r) const {
        const int e = tb.tile_e[u.pm], p = tb.tile_p0[u.pm] + r;
        if (e == NEXP) return (unsigned)p;
        return (p < tb.cnt[e]) ? (unsigned)list[(unsigned)(e * ECAP + p)] : 0u;
    }
};

struct EpiMoe1 {
    static constexpr bool PERM = true; static constexpr bool MIDK = false;
    unsigned char* act; float s;
    __device__ __forceinline__ void operator()(AccRef acc, const Unit& u, int wr, int wc, int fr, int fq) const {
        const int pnl = u.pn & 1;
        const int r0 = wr * 64 + fr, colo = pnl * 128 + wc * 32 + 8 * fq;
#pragma unroll
        for (int ai = 0; ai < 2; ++ai)
#pragma unroll
            for (int m = 0; m < 4; ++m) { const int r = r0 + ai * HALF + m * 16;
                const f32x4 g0 = acc[ai][0][m][0], g1 = acc[ai][0][m][1], u0 = acc[ai][1][m][0], u1 = acc[ai][1][m][1];
                const float ne = -1.4426950408889634f * s, os = s * s * F8A_SCALE;
                float o[8];
#pragma unroll
                for (int j = 0; j < 4; ++j) { o[j] = g0[j] * __builtin_amdgcn_rcpf(1.0f + __builtin_amdgcn_exp2f(g0[j] * ne)) * u0[j]; o[4 + j] = g1[j] * __builtin_amdgcn_rcpf(1.0f + __builtin_amdgcn_exp2f(g1[j] * ne)) * u1[j]; }
                u32x2 w; w.x = pack4_e4m3(o[0], o[1], o[2], o[3], os); w.y = pack4_e4m3(o[4], o[5], o[6], o[7], os);
                *(u32x2*)(act + (unsigned)((u.pm * BM + r) * 256 + colo)) = w; }
    }
};

constexpr float YS_SCALE = 16.0f, YS_INV = 1.0f / 16.0f;
__device__ __forceinline__ unsigned pack4_fp8(const f32x4 v, const float sc) { return pack4_e4m3(v[0], v[1], v[2], v[3], sc); }
struct EpiMoe2 {
    static constexpr bool PERM = true; static constexpr bool MIDK = false;
    MoeTab tb; unsigned char* ys; float ysc;
    __device__ __forceinline__ void operator()(AccRef acc, const Unit& u, int wr, int wc, int fr, int fq) const {
        const int e = tb.tile_e[u.pm], p0 = tb.tile_p0[u.pm], cnt = (e == NEXP) ? NTOK : tb.cnt[e];
        const int yb = (e == NEXP) ? NTOK * 8 : tb.yoff[e];
        const int pnl = u.pn & 3;
        const int r0 = wr * 64 + fr, gran = ((pnl * 4 + wc) * 4 + fq) * 16;
#pragma unroll
        for (int ai = 0; ai < 2; ++ai)
#pragma unroll
            for (int m = 0; m < 4; ++m) { const int p = p0 + r0 + ai * HALF + m * 16;
                if (p < cnt) { u32x4 w; w.x = pack4_fp8(acc[ai][0][m][0], ysc); w.y = pack4_fp8(acc[ai][0][m][1], ysc); w.z = pack4_fp8(acc[ai][1][m][0], ysc); w.w = pack4_fp8(acc[ai][1][m][1], ysc);
                    *(u32x4*)(ys + (unsigned)((yb + p) * 1024 + gran)) = w; } }
    }
};
}
constexpr int NWAVES = 8, NTHR = 512;
constexpr int RING_BYTES = 131072, TAB_OFF = RING_BYTES, LDS_BYTES = 148480;
constexpr int NPHASE = 12;

struct Args {
    const float *x, *c, *w_ada, *b_ada, *w_in, *w_gup, *b_gate, *norm_w, *w_bsb, *w_bgla, *w_out, *ln1_g, *ln1_b, *w_router, *r_bias, *w_egu, *w_edn, *w_sgu, *w_sdn, *ln2_g, *ln2_b;
    float* out; unsigned char* ws; int ph_lo, ph_hi;
};

struct Frame { LAS unsigned char* lds; int tid, lane, wave, G, bid; };

__device__ __forceinline__ void titem_load(const float* W, int N, int item, int lane, f32x4 (&v)[16]) {
    const int nblk = (N + 63) / 64, kb = item / nblk, nb = item % nblk, k0 = 64 * kb + 16 * (lane >> 4), n = 64 * nb + 4 * (lane & 15);
    if (n < N) { const float* src = W + (size_t)k0 * N + n;
#pragma unroll
        for (int i = 0; i < 16; ++i) v[i] = *(const f32x4*)(src + (size_t)i * N); }
}
template <class RowMap>
__device__ __forceinline__ void titem_store(int N, int item, int lane, const f32x4 (&v)[16], const RowMap& rm) {
    const int nblk = (N + 63) / 64, kb = item / nblk, nb = item % nblk, k0 = 64 * kb + 16 * (lane >> 4), n = 64 * nb + 4 * (lane & 15);
    if (n < N) {
#pragma unroll
        for (int c = 0; c < 4; ++c) { bf16_t* dst = rm(n + c) + k0;
#pragma unroll
            for (int j = 0; j < 2; ++j) { u32x4 o; o.x = pk2(v[8 * j][c], v[8 * j + 1][c]); o.y = pk2(v[8 * j + 2][c], v[8 * j + 3][c]); o.z = pk2(v[8 * j + 4][c], v[8 * j + 5][c]); o.w = pk2(v[8 * j + 6][c], v[8 * j + 7][c]);
                *(u32x4*)(dst + 8 * j) = o; } }
    }
}
template <class RowMap8>
__device__ __forceinline__ void titem_store8(int N, int item, int lane, const f32x4 (&v)[16], const RowMap8& rm) {
    const int nblk = (N + 63) / 64, kb = item / nblk, nb = item % nblk, k0 = 64 * kb + 16 * (lane >> 4), n = 64 * nb + 4 * (lane & 15);
    if (n < N) {
#pragma unroll
        for (int c = 0; c < 4; ++c) { u32x4 o;
            o.x = pack4_e4m3(v[0][c], v[1][c], v[2][c], v[3][c], F8W_SCALE); o.y = pack4_e4m3(v[4][c], v[5][c], v[6][c], v[7][c], F8W_SCALE);
            o.z = pack4_e4m3(v[8][c], v[9][c], v[10][c], v[11][c], F8W_SCALE); o.w = pack4_e4m3(v[12][c], v[13][c], v[14][c], v[15][c], F8W_SCALE);
            *(u32x4*)(rm(n + c) + k0) = o; }
    }
}
struct RmGu8 { unsigned char* d; __device__ __forceinline__ unsigned char* operator()(int n) const {
    const int r = n < 256 ? ((n >> 7) * 256 + (n & 127)) : (((n - 256) >> 7) * 256 + 128 + ((n - 256) & 127)); return d + (size_t)r * DM; } };
struct RmPlain8 { unsigned char* d; int K; __device__ __forceinline__ unsigned char* operator()(int n) const { return d + (size_t)n * K; } };
struct RmPlain { bf16_t* d; int K; __device__ __forceinline__ bf16_t* operator()(int n) const { return d + (size_t)n * K; } };
struct RmWin { bf16_t* win; bf16_t* wglr; bf16_t* wv; __device__ __forceinline__ bf16_t* operator()(int n) const {
    if (n < 1024) return win + (size_t)n * DM;
    if (n < 1536) return wv + (size_t)(n - 1024) * DM;
    if (n < 2048) return win + (size_t)(n - 512) * DM;
    if (n < 2560) return wv + (size_t)(n - 2048 + 512) * DM;
    if (n < 3072) return win + (size_t)(n - 1024) * DM;
    if (n < 3088) return wglr + (size_t)(n - 3072) * DM;
    return win + (size_t)(n - 3088 + 2048) * DM; } };
struct RmGu { bf16_t* d; __device__ __forceinline__ bf16_t* operator()(int n) const {
    const int r = n < 256 ? ((n >> 7) * 256 + (n & 127)) : (((n - 256) >> 7) * 256 + 128 + ((n - 256) & 127)); return d + (size_t)r * DM; } };

constexpr int MI_GU1 = 16 * 8, MI_GU = 64 * MI_GU1, MI_DN1 = 4 * 16, MI_DN = 64 * MI_DN1, MOE_ITEMS = MI_GU + MI_GU1 + MI_DN + MI_DN1;
__device__ __forceinline__ void moe_item_load(const Args& a, int it, int lane, f32x4 (&v)[16]) {
    if (it < MI_GU) titem_load(a.w_egu + (size_t)(it / MI_GU1) * DM * 512, 512, it % MI_GU1, lane, v);
    else if (it < MI_GU + MI_GU1) titem_load(a.w_sgu, 512, it - MI_GU, lane, v);
    else if (it < MI_GU + MI_GU1 + MI_DN) { const int r = it - (MI_GU + MI_GU1); titem_load(a.w_edn + (size_t)(r / MI_DN1) * 256 * DM, DM, r % MI_DN1, lane, v); }
    else titem_load(a.w_sdn, DM, it - (MI_GU + MI_GU1 + MI_DN), lane, v);
}
__device__ __forceinline__ void moe_item_store(const Args& a, int it, int lane, const f32x4 (&v)[16]) {
    unsigned char* WGU8 = a.ws + WS_WGU; unsigned char* WDN8 = a.ws + WS_WDN;
    if (it < MI_GU) titem_store8(512, it % MI_GU1, lane, v, RmGu8{WGU8 + (size_t)(it / MI_GU1) * 512 * DM});
    else if (it < MI_GU + MI_GU1) titem_store8(512, it - MI_GU, lane, v, RmGu8{WGU8 + (size_t)64 * 512 * DM});
    else if (it < MI_GU + MI_GU1 + MI_DN) { const int r = it - (MI_GU + MI_GU1); titem_store8(DM, r % MI_DN1, lane, v, RmPlain8{WDN8 + (size_t)(r / MI_DN1) * DM * 256, 256}); }
    else titem_store8(DM, it - (MI_GU + MI_GU1 + MI_DN), lane, v, RmPlain8{WDN8 + (size_t)64 * DM * 256, 256});
}

constexpr int CV_PAIR = 1040, CV_BUF = 64 * CV_PAIR, CV_TILES_GU = 65 * 32, CV_TILES = CV_TILES_GU + 65 * 16;
struct CvTile { const float* src; unsigned char* dst; int N, pitch; };
__device__ __forceinline__ CvTile cv_tile(const Args& a, int t) {
    CvTile c;
    if (t < CV_TILES_GU) { const int e = t >> 5, r = t & 31, kt = r >> 2, nt = r & 3;
        const float* W = e < 64 ? a.w_egu + (size_t)e * DM * 512 : a.w_sgu;
        c.src = W + (size_t)(128 * kt) * 512 + 128 * nt; c.N = 512; c.pitch = DM;
        const int rb = (nt & 1) * 256 + (nt >> 1) * 128;
        c.dst = a.ws + WS_WGU + (size_t)e * 512 * DM + (size_t)rb * DM + 128 * kt; }
    else { const int u = t - CV_TILES_GU, e = u >> 4, r = u & 15, kt = r >> 3, nt = r & 7;
        const float* W = e < 64 ? a.w_edn + (size_t)e * 256 * DM : a.w_sdn;
        c.src = W + (size_t)(128 * kt) * DM + 128 * nt; c.N = DM; c.pitch = 256;
        c.dst = a.ws + WS_WDN + (size_t)e * DM * 256 + (size_t)(128 * nt) * 256 + 128 * kt; }
    return c;
}
__device__ __forceinline__ void cv_issue(Frame& F, const CvTile& c, int buf) {
    const float* g = c.src + (size_t)(16 * F.wave + (F.lane >> 5)) * c.N + 4 * (F.lane & 31);
#pragma unroll
    for (int jj = 0; jj < 8; ++jj)
        __builtin_amdgcn_global_load_lds((const unsigned*)(g + (size_t)(2 * jj) * c.N), (LAS unsigned*)(F.lds + buf * CV_BUF + (8 * F.wave + jj) * CV_PAIR), 16, 0, 2);
}
__device__ __forceinline__ void cv_process(Frame& F, const CvTile& c, int buf) {
    const int cg = F.wave & 3, kh = F.wave >> 2, nl = 32 * cg + (F.lane & 31);
    const LAS unsigned char* L = F.lds + buf * CV_BUF + nl * 4;
#pragma unroll
    for (int p = 0; p < 2; ++p) { const int kb = 64 * kh + 32 * p + 16 * (F.lane >> 5);
        float v[16];
#pragma unroll
        for (int i = 0; i < 16; ++i) { const int k = kb + i; v[i] = *(const LAS float*)(L + (k >> 1) * CV_PAIR + (k & 1) * 512); }
        u32x4 o; o.x = pack4_e4m3(v[0], v[1], v[2], v[3], F8W_SCALE); o.y = pack4_e4m3(v[4], v[5], v[6], v[7], F8W_SCALE);
        o.z = pack4_e4m3(v[8], v[9], v[10], v[11], F8W_SCALE); o.w = pack4_e4m3(v[12], v[13], v[14], v[15], F8W_SCALE);
        *(u32x4*)(c.dst + (size_t)nl * c.pitch + kb) = o; }
}
__device__ __forceinline__ void cv_phase(Frame& F, const Args& a) {
    int t = F.bid;
    if (t < CV_TILES) { const CvTile c0 = cv_tile(a, t); cv_issue(F, c0, 0); }
    for (int it = 0; t < CV_TILES; ++it, t += F.G) {
        const CvTile c = cv_tile(a, t);
        const int tn = t + F.G; const bool hn = tn < CV_TILES;
        if (hn) { const CvTile cn = cv_tile(a, tn); cv_issue(F, cn, (it + 1) & 1); }
        if (!hn) asm volatile("s_waitcnt vmcnt(0)" ::: "memory"); else if (it == 0) asm volatile("s_waitcnt vmcnt(8)" ::: "memory"); else asm volatile("s_waitcnt vmcnt(10)" ::: "memory");
        __builtin_amdgcn_s_barrier();
        cv_process(F, c, it & 1);
        asm volatile("s_waitcnt lgkmcnt(0)" ::: "memory");
        __builtin_amdgcn_s_barrier();
    }
    asm volatile("s_waitcnt vmcnt(0)" ::: "memory");
    __builtin_amdgcn_s_barrier();
}

__device__ __forceinline__ void p0_phase(Frame& F, const Args& a) {
    unsigned char* ws = a.ws;
    if (F.bid < 192) {
        LAS float* sc = (LAS float*)F.lds;
        LAS float* red = (LAS float*)(F.lds + 32768);
        const int cl = F.tid & 31, col = F.bid * 32 + cl, kg = F.tid >> 5;
        float wa[16], wb[16];
#define ADA_LD(w_, kb_) { _Pragma("unroll") for (int i = 0; i < 16; ++i) w_[i] = a.w_ada[(size_t)(kg * 64 + 16 * (kb_) + i) * 6144 + col]; }
#define ADA_FMA(w_, kb_) { _Pragma("unroll") for (int i = 0; i < 16; ++i) { _Pragma("unroll") for (int b = 0; b < 8; ++b) acc[b] += sc[b * DM + kg * 64 + 16 * (kb_) + i] * w_[i]; } }
        ADA_LD(wa, 0)
        { float cv_[16];
#pragma unroll
          for (int j = 0; j < 16; ++j) cv_[j] = a.c[F.tid + j * NTHR];
#pragma unroll
          for (int j = 0; j < 16; ++j) sc[F.tid + j * NTHR] = cv_[j] * sigmoidf_(cv_[j]); }
        __syncthreads();
        float acc[8];
#pragma unroll
        for (int b = 0; b < 8; ++b) acc[b] = 0.f;
        ADA_LD(wb, 1) ADA_FMA(wa, 0)
        ADA_LD(wa, 2) ADA_FMA(wb, 1)
        ADA_LD(wb, 3) ADA_FMA(wa, 2)
        ADA_FMA(wb, 3)
#undef ADA_LD
#undef ADA_FMA
#pragma unroll
        for (int b = 0; b < 8; ++b) red[(kg * 8 + b) * 32 + cl] = acc[b];
        __syncthreads();
        if (F.tid < 256) { const int b = F.tid >> 5; float s = a.b_ada[F.bid * 32 + cl];
#pragma unroll
          for (int g = 0; g < 16; ++g) s += red[(g * 8 + b) * 32 + cl];
          ((float*)(ws + WS_MOD))[b * 6144 + F.bid * 32 + cl] = s; }
        __syncthreads();
    }
    const int gw = F.bid * NWAVES + F.wave, NGW = F.G * NWAVES;
    bf16_t* WIN = (bf16_t*)(ws + WS_WIN); bf16_t* WGLR = (bf16_t*)(ws + WS_WSM); bf16_t* WR = (bf16_t*)(ws + WS_WSM + 65536);
    constexpr int I_IN = 16 * 81, I_B = 8 * 16, I_O = 16 * 16, I_R = 16 * 1;
    constexpr int NITEMS = I_IN + 2 * I_B + I_O + I_R;
    for (int it = gw; it < NITEMS; it += NGW) {
        int r = it; f32x4 v[16];
        if (r < I_IN) { titem_load(a.w_in, 5136, r, F.lane, v); titem_store(5136, r, F.lane, v, RmWin{WIN, WGLR, (bf16_t*)(ws + WS_WV)}); continue; } r -= I_IN;
        if (r < I_B) { titem_load(a.w_bsb, DM, r, F.lane, v); titem_store(DM, r, F.lane, v, RmPlain{(bf16_t*)(ws + WS_WCAT), DM}); continue; } r -= I_B;
        if (r < I_B) { titem_load(a.w_bgla, DM, r, F.lane, v); titem_store(DM, r, F.lane, v, RmPlain{(bf16_t*)(ws + WS_WCAT) + 512, DM}); continue; } r -= I_B;
        if (r < I_O) { titem_load(a.w_out, DM, r, F.lane, v); titem_store(DM, r, F.lane, v, RmPlain{(bf16_t*)(ws + WS_WOUT), DM}); continue; } r -= I_O;
        titem_load(a.w_router, 64, r, F.lane, v); titem_store(64, r, F.lane, v, RmPlain{WR, DM});
    }
}

__device__ __forceinline__ void p1_phase(Frame& F, const Args& a) {
    const float* mod = (const float*)(a.ws + WS_MOD); bf16_t* H = (bf16_t*)(a.ws + WS_H1);
    const int gw = F.bid * NWAVES + F.wave, NGW = F.G * NWAVES;
    for (int m0 = gw * 8; m0 < NTOK; m0 += NGW * 8) {
        const int b = m0 >> 11;
        f32x4 sh[4], sc[4];
#pragma unroll
        for (int j = 0; j < 4; ++j) { sh[j] = *((const f32x4*)(mod + b * 6144) + F.lane + 64 * j); sc[j] = *((const f32x4*)(mod + b * 6144 + DM) + F.lane + 64 * j) + 1.0f; }
#pragma unroll
        for (int h4 = 0; h4 < 2; ++h4) {
            f32x4 v[4][4];
#pragma unroll
            for (int r = 0; r < 4; ++r) { const f32x4* xr = (const f32x4*)(a.x + (size_t)(m0 + 4 * h4 + r) * DM) + F.lane;
#pragma unroll
                for (int j = 0; j < 4; ++j) v[r][j] = __builtin_nontemporal_load(xr + 64 * j); }
#pragma unroll
            for (int r = 0; r < 4; ++r) {
                const int m = m0 + 4 * h4 + r; float s = 0.f;
#pragma unroll
                for (int j = 0; j < 4; ++j) s += (v[r][j].x + v[r][j].y) + (v[r][j].z + v[r][j].w);
                const float mean = wave_sum(s) * (1.f / DM); float s2 = 0.f;
#pragma unroll
                for (int j = 0; j < 4; ++j) { v[r][j] = v[r][j] - mean; s2 += (v[r][j].x * v[r][j].x + v[r][j].y * v[r][j].y) + (v[r][j].z * v[r][j].z + v[r][j].w * v[r][j].w); }
                const float rstd = 1.f / sqrtf(wave_sum(s2) * (1.f / DM) + LN_EPS);
                u32x2* o8 = (u32x2*)(H + (size_t)m * DM) + F.lane;
#pragma unroll
                for (int j = 0; j < 4; ++j) { const f32x4 y = v[r][j] * rstd * sc[j] + sh[j]; u32x2 w; w.x = pk2(y.x, y.y); w.y = pk2(y.z, y.w); o8[64 * j] = w; }
            }
        }
    }
}

constexpr int GLR_WROW = 2064;
__device__ __forceinline__ void glr_stage(Frame& F, const Args& a) {
    const bf16_t* W = (const bf16_t*)(a.ws + WS_WSM);
    for (int i = F.tid; i < 16 * 128; i += NTHR) { const int row = i >> 7, piece = i & 127; *(LAS u32x4*)(F.lds + row * GLR_WROW + piece * 16) = *(const u32x4*)(W + row * DM + piece * 8); }
}
__device__ __forceinline__ void glr_tile(Frame& F, const Args& a, int tile) {
    const bf16_t* H = (const bf16_t*)(a.ws + WS_H1); float* GLR = (float*)(a.ws + WS_GLR);
    const int l15 = F.lane & 15, q = F.lane >> 4;
    const bf16_t* ap = H + (size_t)(tile * 16 + l15) * DM + 8 * q; const LAS unsigned char* bp = F.lds + l15 * GLR_WROW + 16 * q;
    bf16x8 af[32];
#pragma unroll
    for (int k = 0; k < 32; ++k) af[k] = *(const bf16x8*)(ap + 32 * k);
    f32x4 acc = {0.f, 0.f, 0.f, 0.f};
#pragma unroll
    for (int k = 0; k < 32; ++k) acc = __builtin_amdgcn_mfma_f32_16x16x32_bf16(af[k], *(const LAS bf16x8*)(bp + 64 * k), acc, 0, 0, 0);
#pragma unroll
    for (int r = 0; r < 4; ++r) GLR[(size_t)(tile * 16 + q * 4 + r) * 16 + l15] = acc[r];
}

__device__ __forceinline__ int crow(int r, int hi) { return (r & 3) + 8 * (r >> 2) + 4 * hi; }
constexpr float SB_SKIP = -93.0f;
constexpr int SBK_ROW = 144, SBV_ROW = 80, SB_LDS = 32 * SBK_ROW + 64 * SBV_ROW;
__device__ __forceinline__ void sb_unit(int bh, int qb, const bf16_t* PROJ, const bf16_t* VT, bf16_t* OCAT, int lane, const Args& a, int& cit, int cstep, LAS unsigned char* ks) {
    LAS unsigned char* vs = ks + 32 * SBK_ROW;
    const int b = bh >> 3, h = bh & 7, r32 = lane & 31, hi = lane >> 5, q0 = qb * 32, q = q0 + r32;
    const size_t rowbase = (size_t)b * SEQ;
    bf16x8 qf[4];
    { const bf16_t* qp = PROJ + (rowbase + q) * PW + C_QSB + h * 64 + hi * 8;
#pragma unroll
      for (int s = 0; s < 4; ++s) qf[s] = *(const bf16x8*)(qp + 16 * s); }
    float carry = 0.f;
    f32x16 o0, o1;
#pragma unroll
    for (int r = 0; r < 16; ++r) { o0[r] = 0.f; o1[r] = 0.f; }
    const bf16_t* kg0 = PROJ + (rowbase + (lane >> 3)) * PW + C_KSB + h * 64 + 8 * (lane & 7);
    const bf16_t* vg0 = VT + ((size_t)b * 1024 + h * 64 + (lane >> 2)) * SEQ + 8 * (lane & 3);
    const LAS unsigned char* kfrag = ks + r32 * SBK_ROW + 16 * hi;
    const LAS unsigned char* vfrag = vs + r32 * SBV_ROW + 8 * hi;
    u32x4 kn[4], vn[4];
#define SB_LOAD(kb_) do { _Pragma("unroll") for (int i = 0; i < 4; ++i) { kn[i] = *(const u32x4*)(kg0 + (size_t)((kb_) * 32 + 8 * i) * PW); vn[i] = *(const u32x4*)(vg0 + (size_t)(16 * i) * SEQ + (kb_) * 32); } } while (0)
    SB_LOAD(qb);
    for (int kb = qb; kb >= 0; --kb) {
        const int k0 = kb * 32;
        const bool have = (cit < MOE_ITEMS) && (kb & 1); f32x4 cv[16];
        if (have) moe_item_load(a, cit, lane, cv);
#pragma unroll
        for (int i = 0; i < 4; ++i) { *(LAS u32x4*)(ks + (8 * i + (lane >> 3)) * SBK_ROW + 16 * (lane & 7)) = kn[i]; *(LAS u32x4*)(vs + (16 * i + (lane >> 2)) * SBV_ROW + 16 * (lane & 3)) = vn[i]; }
        LDS_WAIT(); asm volatile("" ::: "memory");
        if (kb > 0) SB_LOAD(kb - 1);
        bf16x8 kc[4]; u32x2 vc[2][2][2];
#pragma unroll
        for (int s = 0; s < 4; ++s) kc[s] = *(const LAS bf16x8*)(kfrag + 32 * s);
#pragma unroll
        for (int s = 0; s < 2; ++s)
#pragma unroll
            for (int d0 = 0; d0 < 2; ++d0) { vc[s][d0][0] = *(const LAS u32x2*)(vfrag + 32 * SBV_ROW * d0 + 32 * s); vc[s][d0][1] = *(const LAS u32x2*)(vfrag + 32 * SBV_ROW * d0 + 32 * s + 16); }
        LDS_WAIT(); asm volatile("" ::: "memory");
        f32x16 p;
#pragma unroll
        for (int r = 0; r < 16; ++r) p[r] = 0.f;
#pragma unroll
        for (int s = 0; s < 4; ++s) p = __builtin_amdgcn_mfma_f32_32x32x16_bf16(kc[s], qf[s], p, 0, 0, 0);
        float lb[16], l1[16];
        const bool diag = (kb == qb);
#pragma unroll
        for (int r = 0; r < 16; ++r) {
            const float z = p[r] * 0.125f;
            const float t = flog(1.0f + fexp(-fabsf(z)));
            lb[r] = fminf(z, 0.f) - t; l1[r] = fminf(-z, 0.f) - t;
            if (diag) { const bool valid = (k0 + crow(r, hi)) < q; if (!valid) { lb[r] = -INFINITY; l1[r] = 0.f; } }
        }
        float G[4], PG[4];
#pragma unroll
        for (int g = 0; g < 4; ++g) { G[g] = (l1[4 * g] + l1[4 * g + 1]) + (l1[4 * g + 2] + l1[4 * g + 3]);
            const auto rr = __builtin_amdgcn_permlane32_swap(__builtin_bit_cast(unsigned, G[g]), __builtin_bit_cast(unsigned, G[g]), false, false);
            PG[g] = __builtin_bit_cast(float, hi ? rr[0] : rr[1]); }
        float T[4]; T[3] = 0.f;
#pragma unroll
        for (int g = 2; g >= 0; --g) T[g] = T[g + 1] + G[g + 1] + PG[g + 1];
        float w[16];
#pragma unroll
        for (int g = 0; g < 4; ++g) {
            const float base = carry + T[g] + (hi == 0 ? PG[g] : 0.f);
            const float s3 = l1[4 * g + 3], s2 = s3 + l1[4 * g + 2], s1 = s2 + l1[4 * g + 1];
            w[4 * g + 3] = fexp(lb[4 * g + 3] + base);
            w[4 * g + 2] = fexp(lb[4 * g + 2] + base + s3);
            w[4 * g + 1] = fexp(lb[4 * g + 1] + base + s2);
            w[4 * g + 0] = fexp(lb[4 * g + 0] + base + s1);
        }
        carry += (T[0] + G[0] + PG[0]);
#pragma unroll
        for (int s = 0; s < 2; ++s) {
            u32x4 wb; wb.x = pk2(w[8 * s], w[8 * s + 1]); wb.y = pk2(w[8 * s + 2], w[8 * s + 3]); wb.z = pk2(w[8 * s + 4], w[8 * s + 5]); wb.w = pk2(w[8 * s + 6], w[8 * s + 7]);
            const bf16x8 wf = __builtin_bit_cast(bf16x8, wb);
            { u32x4 av; av.x = vc[s][0][0].x; av.y = vc[s][0][0].y; av.z = vc[s][0][1].x; av.w = vc[s][0][1].y; o0 = __builtin_amdgcn_mfma_f32_32x32x16_bf16(__builtin_bit_cast(bf16x8, av), wf, o0, 0, 0, 0); }
            { u32x4 av; av.x = vc[s][1][0].x; av.y = vc[s][1][0].y; av.z = vc[s][1][1].x; av.w = vc[s][1][1].y; o1 = __builtin_amdgcn_mfma_f32_32x32x16_bf16(__builtin_bit_cast(bf16x8, av), wf, o1, 0, 0, 0); }
        }
        if (have) { moe_item_store(a, cit, lane, cv); cit += cstep; }
        if (__all(carry < SB_SKIP)) break;
    }
#undef SB_LOAD
    bf16_t* op = OCAT + (rowbase + q) * DM + h * 64 + 4 * hi;
#pragma unroll
    for (int g = 0; g < 4; ++g) {
        u32x2 w0; w0.x = pk2(o0[4 * g], o0[4 * g + 1]); w0.y = pk2(o0[4 * g + 2], o0[4 * g + 3]); *(u32x2*)(op + 8 * g) = w0;
        u32x2 w1; w1.x = pk2(o1[4 * g], o1[4 * g + 1]); w1.y = pk2(o1[4 * g + 2], o1[4 * g + 3]); *(u32x2*)(op + 32 + 8 * g) = w1;
    }
}

constexpr int SBW = 14, SB_FLAG = SBW * SB_LDS;
#define SB_BLOCK(DIAG_) { \
                const int k0 = kb * 32; \
                const LAS unsigned char* ks = L + (whi - kb) * SB_LDS; \
                const LAS unsigned char* kfrag = ks + r32 * SBK_ROW + 16 * hi; \
                const LAS unsigned char* vfrag = ks + 32 * SBK_ROW + r32 * SBV_ROW + 8 * hi; \
        bf16x8 kc[4]; \
        _Pragma("unroll") \
        for (int s = 0; s < 4; ++s) kc[s] = *(const LAS bf16x8*)(kfrag + 32 * s); \
        f32x16 p; \
        _Pragma("unroll") \
        for (int r = 0; r < 16; ++r) p[r] = 0.f; \
        _Pragma("unroll") \
        for (int s = 0; s < 4; ++s) p = __builtin_amdgcn_mfma_f32_32x32x16_bf16(kc[s], qf[s], p, 0, 0, 0); \
        float lb[16], l1[16]; \
        _Pragma("unroll") \
        for (int r = 0; r < 16; ++r) { \
            const float z = p[r] * (0.125f * 1.4426950408889634f); \
            const float t = __builtin_amdgcn_logf(1.0f + __builtin_amdgcn_exp2f(-fabsf(z))); \
            lb[r] = fminf(z, 0.f) - t; l1[r] = fminf(-z, 0.f) - t; \
            if (DIAG_) { const bool valid = (k0 + crow(r, hi)) < q; if (!valid) { lb[r] = -INFINITY; l1[r] = 0.f; } } \
        } \
        float G[4], PG[4]; \
        _Pragma("unroll") \
        for (int g = 0; g < 4; ++g) { G[g] = (l1[4 * g] + l1[4 * g + 1]) + (l1[4 * g + 2] + l1[4 * g + 3]); \
            const auto rr = __builtin_amdgcn_permlane32_swap(__builtin_bit_cast(unsigned, G[g]), __builtin_bit_cast(unsigned, G[g]), false, false); \
            PG[g] = __builtin_bit_cast(float, hi ? rr[0] : rr[1]); } \
        float T[4]; T[3] = 0.f; \
        _Pragma("unroll") \
        for (int g = 2; g >= 0; --g) T[g] = T[g + 1] + G[g + 1] + PG[g + 1]; \
        float w[16]; \
        _Pragma("unroll") \
        for (int g = 0; g < 4; ++g) { \
            const float base = carry + T[g] + (hi == 0 ? PG[g] : 0.f); \
            const float s3 = l1[4 * g + 3], s2 = s3 + l1[4 * g + 2], s1 = s2 + l1[4 * g + 1]; \
            w[4 * g + 3] = __builtin_amdgcn_exp2f(lb[4 * g + 3] + base); \
            w[4 * g + 2] = __builtin_amdgcn_exp2f(lb[4 * g + 2] + base + s3); \
            w[4 * g + 1] = __builtin_amdgcn_exp2f(lb[4 * g + 1] + base + s2); \
            w[4 * g + 0] = __builtin_amdgcn_exp2f(lb[4 * g + 0] + base + s1); \
        } \
        carry += (T[0] + G[0] + PG[0]); \
        u32x2 vc[2][2][2]; \
        _Pragma("unroll") \
        for (int s = 0; s < 2; ++s) \
        _Pragma("unroll") \
            for (int d0 = 0; d0 < 2; ++d0) { vc[s][d0][0] = *(const LAS u32x2*)(vfrag + 32 * SBV_ROW * d0 + 32 * s); vc[s][d0][1] = *(const LAS u32x2*)(vfrag + 32 * SBV_ROW * d0 + 32 * s + 16); } \
        _Pragma("unroll") \
        for (int s = 0; s < 2; ++s) { \
            u32x4 wb; wb.x = pk2(w[8 * s], w[8 * s + 1]); wb.y = pk2(w[8 * s + 2], w[8 * s + 3]); wb.z = pk2(w[8 * s + 4], w[8 * s + 5]); wb.w = pk2(w[8 * s + 6], w[8 * s + 7]); \
            const bf16x8 wf = __builtin_bit_cast(bf16x8, wb); \
            { u32x4 av; av.x = vc[s][0][0].x; av.y = vc[s][0][0].y; av.z = vc[s][0][1].x; av.w = vc[s][0][1].y; o0 = __builtin_amdgcn_mfma_f32_32x32x16_bf16(__builtin_bit_cast(bf16x8, av), wf, o0, 0, 0, 0); } \
            { u32x4 av; av.x = vc[s][1][0].x; av.y = vc[s][1][0].y; av.z = vc[s][1][1].x; av.w = vc[s][1][1].y; o1 = __builtin_amdgcn_mfma_f32_32x32x16_bf16(__builtin_bit_cast(bf16x8, av), wf, o1, 0, 0, 0); } \
        } \
    }
__device__ __forceinline__ void sb_unit_shared(Frame& F, int bh, int qb, int qmax, const bf16_t* PROJ, const bf16_t* VT, bf16_t* OCAT, const Args& a, int& cit, int cstep) {
    int lane_ = F.lane; asm volatile("" : "+v"(lane_));
    const int lane = lane_; LAS unsigned char* L = F.lds;
    const int b = bh >> 3, h = bh & 7, r32 = lane & 31, hi = lane >> 5, q0 = qb * 32, q = q0 + r32;
    const size_t rowbase = (size_t)b * SEQ;
    bf16x8 qf[4];
    { const bf16_t* qp = PROJ + (rowbase + q) * PW + C_QSB + h * 64 + hi * 8;
#pragma unroll
      for (int s = 0; s < 4; ++s) qf[s] = *(const bf16x8*)(qp + 16 * s); }
    float carry = 0.f;
    f32x16 o0, o1;
#pragma unroll
    for (int r = 0; r < 16; ++r) { o0[r] = 0.f; o1[r] = 0.f; }
    const bf16_t* kg0 = PROJ + (rowbase + (lane >> 3)) * PW + C_KSB + h * 64 + 8 * (lane & 7);
    const bf16_t* vg0 = VT + ((size_t)b * 1024 + h * 64 + (lane >> 2)) * SEQ + 8 * (lane & 3);
    volatile LAS int* flag = (volatile LAS int*)(L + SB_FLAG);
    if (F.tid == 0) { flag[0] = 0; flag[1] = 0; }
    bool live = true; int kb = qb, par = 0;
    for (int whi = qmax; ; whi -= SBW) {
        const int wlo = (whi - (SBW - 1)) > 0 ? whi - (SBW - 1) : 0;
        { const int s0 = F.wave, s1 = F.wave + 8, b0 = whi - s0, b1 = whi - s1;
          const bool v0 = b0 >= wlo, v1 = (s1 < SBW) && (b1 >= wlo);
          u32x4 kn[4], vn[4], kn2[4], vn2[4];
          if (v0) {
#pragma unroll
              for (int i = 0; i < 4; ++i) { kn[i] = *(const u32x4*)(kg0 + (size_t)(b0 * 32 + 8 * i) * PW); vn[i] = *(const u32x4*)(vg0 + (size_t)(16 * i) * SEQ + b0 * 32); } }
          if (v1) {
#pragma unroll
              for (int i = 0; i < 4; ++i) { kn2[i] = *(const u32x4*)(kg0 + (size_t)(b1 * 32 + 8 * i) * PW); vn2[i] = *(const u32x4*)(vg0 + (size_t)(16 * i) * SEQ + b1 * 32); } }
          if (v0) { LAS unsigned char* ks = L + s0 * SB_LDS; LAS unsigned char* vs = ks + 32 * SBK_ROW;
#pragma unroll
              for (int i = 0; i < 4; ++i) { *(LAS u32x4*)(ks + (8 * i + (lane >> 3)) * SBK_ROW + 16 * (lane & 7)) = kn[i]; *(LAS u32x4*)(vs + (16 * i + (lane >> 2)) * SBV_ROW + 16 * (lane & 3)) = vn[i]; } }
          if (v1) { LAS unsigned char* ks = L + s1 * SB_LDS; LAS unsigned char* vs = ks + 32 * SBK_ROW;
#pragma unroll
              for (int i = 0; i < 4; ++i) { *(LAS u32x4*)(ks + (8 * i + (lane >> 3)) * SBK_ROW + 16 * (lane & 7)) = kn2[i]; *(LAS u32x4*)(vs + (16 * i + (lane >> 2)) * SBV_ROW + 16 * (lane & 3)) = vn2[i]; } }
        }
        __syncthreads();
        if (F.tid == 0) flag[par ^ 1] = 0;
        if (live) {
            for (; kb >= wlo; --kb) {
                if (kb == qb) SB_BLOCK(true) else SB_BLOCK(false)
                if (__all(carry < SB_SKIP * 1.4426950408889634f)) { live = false; break; }
            }
            if (kb < 0) live = false;
        }
        if (live && lane == 0) flag[par] = 1;
        __syncthreads();
        const int any = flag[par]; par ^= 1;
        if (!any) break;
    }
    bf16_t* op = OCAT + (rowbase + q) * DM + h * 64 + 4 * hi;
#pragma unroll
    for (int g = 0; g < 4; ++g) {
        u32x2 w0; w0.x = pk2(o0[4 * g], o0[4 * g + 1]); w0.y = pk2(o0[4 * g + 2], o0[4 * g + 3]); *(u32x2*)(op + 8 * g) = w0;
        u32x2 w1; w1.x = pk2(o1[4 * g], o1[4 * g + 1]); w1.y = pk2(o1[4 * g + 2], o1[4 * g + 3]); *(u32x2*)(op + 32 + 8 * g) = w1;
    }
}
#undef SB_BLOCK

constexpr int GL_GA = 0, GL_GLR = 16384, GL_WUP = 20480, GL_GS = 24576, GL_QS = 26624, GL_KD = 35840, GL_KLT = 45056, GL_PP = 54272, GL_RMS = 63488, GLS = 72;
constexpr int GL_OT = 65536, GL_OTS = 136;
struct PrepIn { float glr[2], wup[2], bias; };
__device__ __forceinline__ void prep_load(Frame& F, const Args& a, int bh, int c, PrepIn& P) {
    const int b = bh >> 2, h = bh & 3, tok0 = b * SEQ + c * 64;
    const float* GLR = (const float*)(a.ws + WS_GLR);
#pragma unroll
    for (int k = 0; k < 2; ++k) { const int i = F.tid + k * NTHR; P.glr[k] = GLR[(size_t)tok0 * 16 + i]; P.wup[k] = a.w_gup[(i >> 6) * 256 + h * 64 + (i & 63)]; }
    P.bias = a.b_gate[h * 64 + (F.tid & 63)];
}
__device__ __forceinline__ void gla_prep(Frame& F, const Args& a, int bh, int c, const PrepIn& P) {
    const int h = bh & 3;
    LAS float* GAm = (LAS float*)(F.lds + GL_GA); LAS float* GLRs = (LAS float*)(F.lds + GL_GLR); LAS float* WUP = (LAS float*)(F.lds + GL_WUP); LAS float* GS = (LAS float*)(F.lds + GL_GS);
#pragma unroll
    for (int k = 0; k < 2; ++k) { const int i = F.tid + k * NTHR; GLRs[i] = P.glr[k]; WUP[i] = P.wup[k]; }
    __syncthreads();
    const int d = F.tid & 63, tg = F.tid >> 6;
    float wcol[16];
#pragma unroll
    for (int r = 0; r < 16; ++r) wcol[r] = WUP[r * 64 + d];
    const float bias = P.bias; (void)h;
    float loc[8]; float run = 0.f;
#pragma unroll
    for (int i = 0; i < 8; ++i) { const int t = tg * 8 + i; float xv = bias;
#pragma unroll
        for (int r = 0; r < 16; ++r) xv += GLRs[t * 16 + r] * wcol[r];
        run += logsigmoid_(xv) * (1.0f / 16.0f); loc[i] = run; }
    GS[tg * 64 + d] = run;
    __syncthreads();
    float pre = 0.f;
#pragma unroll
    for (int g = 0; g < 8; ++g) pre += (g < tg) ? GS[g * 64 + d] : 0.f;
#pragma unroll
    for (int i = 0; i < 8; ++i) GAm[(tg * 8 + i) * 64 + d] = loc[i] + pre;
    __syncthreads();
}
struct G1In { unsigned short kraw[8]; bf16x8 a0, a1; PrepIn P; };
__device__ __forceinline__ void g1_load(Frame& F, const Args& a, int unit, G1In& R) {
    const int bh = unit >> 5, c = unit & 31, b = bh >> 2, h = bh & 3, tok0 = b * SEQ + c * 64;
    const bf16_t* PROJ = (const bf16_t*)(a.ws + WS_PROJ); const bf16_t* VTG = (const bf16_t*)(a.ws + WS_VT) + ((size_t)b * 1024 + 512 + h * 128) * SEQ;
    const int d = F.tid & 63, tg = F.tid >> 6, l15 = F.lane & 15, q = F.lane >> 4;
#pragma unroll
    for (int i = 0; i < 8; ++i) R.kraw[i] = PROJ[(size_t)(tok0 + tg * 8 + i) * PW + C_KG + h * 64 + d];
    const bf16_t* ap = VTG + ((size_t)16 * F.wave + l15) * SEQ + c * 64 + 8 * q;
    R.a0 = *(const bf16x8*)ap; R.a1 = *(const bf16x8*)(ap + 32);
    prep_load(F, a, bh, c, R.P);
}
__device__ __forceinline__ void gla_g1(Frame& F, const Args& a, int unit, const G1In& R) {
    const int bh = unit >> 5, c = unit & 31;
    LAS float* GAm = (LAS float*)(F.lds + GL_GA); LAS bf16_t* KLT = (LAS bf16_t*)(F.lds + GL_KLT);
    float* KVT = (float*)(a.ws + WS_KVT); float* DEC = (float*)(a.ws + WS_DEC);
    const int d = F.tid & 63, tg = F.tid >> 6, l15 = F.lane & 15, q = F.lane >> 4;
    const bf16x8 a0 = R.a0, a1 = R.a1;
    gla_prep(F, a, bh, c, R.P);
    const float glast = GAm[63 * 64 + d];
#pragma unroll
    for (int i = 0; i < 8; ++i) { const int t = tg * 8 + i; KLT[d * GLS + t] = (bf16_t)f2bf(bf2f(R.kraw[i]) * fexp(glast - GAm[t * 64 + d])); }
    if (tg == 0) DEC[unit * 64 + d] = fexp(glast);
    __syncthreads();
#pragma unroll
    for (int tn = 0; tn < 4; ++tn) {
        const LAS bf16_t* bp = KLT + (16 * tn + l15) * GLS + 8 * q;
        f32x4 acc = {0.f, 0.f, 0.f, 0.f};
        acc = __builtin_amdgcn_mfma_f32_16x16x32_bf16(a0, *(const LAS bf16x8*)bp, acc, 0, 0, 0);
        acc = __builtin_amdgcn_mfma_f32_16x16x32_bf16(a1, *(const LAS bf16x8*)(bp + 32), acc, 0, 0, 0);
#pragma unroll
        for (int r = 0; r < 4; ++r) KVT[((size_t)unit * 128 + 16 * F.wave + q * 4 + r) * 64 + 16 * tn + l15] = acc[r];
    }
    __syncthreads();
}
__device__ __forceinline__ void gla_scan(Frame& F, const Args& a) {
    const float* KVT = (const float*)(a.ws + WS_KVT); const float* DEC = (const float*)(a.ws + WS_DEC); bf16_t* ST = (bf16_t*)(a.ws + WS_ST16);
    for (int e = F.bid * NTHR + F.tid; e < 32 * 8192; e += F.G * NTHR) {
        const int bh = e >> 13, rem = e & 8191, d = rem & 63; float S = 0.f;
        float kv[32], dc[32];
#pragma unroll
        for (int c = 0; c < 32; ++c) { const int unit = bh * 32 + c; kv[c] = KVT[(size_t)unit * 8192 + rem]; dc[c] = DEC[unit * 64 + d]; }
#pragma unroll
        for (int c = 0; c < 32; ++c) { const int unit = bh * 32 + c; ST[(size_t)unit * 8192 + rem] = (bf16_t)f2bf(S); S = dc[c] * S + kv[c]; }
    }
}
struct G3In { u32x4 q8, k8; u32x4 rg2[2]; bf16x8 bv0, bv1, bs0, bs1; PrepIn P; };
__device__ __forceinline__ void g3_load(Frame& F, const Args& a, int unit, G3In& R) {
    const int bh = unit >> 5, c = unit & 31, b = bh >> 2, h = bh & 3, tok0 = b * SEQ + c * 64;
    const bf16_t* PROJ = (const bf16_t*)(a.ws + WS_PROJ); const bf16_t* VTG = (const bf16_t*)(a.ws + WS_VT) + ((size_t)b * 1024 + 512 + h * 128) * SEQ; const bf16_t* ST = (const bf16_t*)(a.ws + WS_ST16);
    const int l15 = F.lane & 15, q = F.lane >> 4;
    { const bf16_t* rp = PROJ + (size_t)(tok0 + (F.tid >> 3)) * PW + h * 64 + 8 * (F.tid & 7); R.q8 = *(const u32x4*)(rp + C_QG); R.k8 = *(const u32x4*)(rp + C_KG); }
    const bf16_t* vp_ = VTG + ((size_t)16 * F.wave + l15) * SEQ + c * 64 + 8 * q; const bf16_t* sp_ = ST + ((size_t)unit * 128 + 16 * F.wave + l15) * 64 + 8 * q;
    R.bv0 = *(const bf16x8*)vp_; R.bv1 = *(const bf16x8*)(vp_ + 32); R.bs0 = *(const bf16x8*)sp_; R.bs1 = *(const bf16x8*)(sp_ + 32);
    { const u32x4* rp = (const u32x4*)(PROJ + (size_t)(tok0 + (F.tid >> 3)) * PW + C_RG + h * 128 + 16 * (F.tid & 7)); R.rg2[0] = rp[0]; R.rg2[1] = rp[1]; }
    prep_load(F, a, bh, c, R.P);
}
__device__ __forceinline__ void gla_g3(Frame& F, const Args& a, int unit, const G3In& R) {
    const int bh = unit >> 5, c = unit & 31, b = bh >> 2, h = bh & 3, tok0 = b * SEQ + c * 64;
    LAS float* GAm = (LAS float*)(F.lds + GL_GA); LAS bf16_t* QS = (LAS bf16_t*)(F.lds + GL_QS); LAS bf16_t* KD = (LAS bf16_t*)(F.lds + GL_KD); LAS bf16_t* PP = (LAS bf16_t*)(F.lds + GL_PP);
    LAS float* RMS = (LAS float*)(F.lds + GL_RMS);
    bf16_t* OG = (bf16_t*)(a.ws + WS_OCAT) + 512;
    const int l15 = F.lane & 15, q = F.lane >> 4;
    const bf16x8 bv0 = R.bv0, bv1 = R.bv1, bs0 = R.bs0, bs1 = R.bs1;
    gla_prep(F, a, bh, c, R.P);
    { const int t = F.tid >> 3, d0 = 8 * (F.tid & 7);
      const f32x4 ga = *(const LAS f32x4*)(GAm + t * 64 + d0), gb = *(const LAS f32x4*)(GAm + t * 64 + d0 + 4);
      u32x4 qo, ko;
#pragma unroll
      for (int j = 0; j < 4; ++j) { const float g0 = j < 2 ? ga[2 * j] : gb[2 * j - 4], g1 = j < 2 ? ga[2 * j + 1] : gb[2 * j - 3];
          qo[j] = pk2(bflo(R.q8[j]) * 0.125f * fexp(g0), bfhi(R.q8[j]) * 0.125f * fexp(g1));
          ko[j] = pk2(bflo(R.k8[j]) * fexp(-g0), bfhi(R.k8[j]) * fexp(-g1)); }
      *(LAS u32x4*)(QS + t * GLS + d0) = qo; *(LAS u32x4*)(KD + t * GLS + d0) = ko; }
    __syncthreads();
    { const int tm = F.wave >> 1; const LAS bf16_t* ap = QS + (16 * tm + l15) * GLS + 8 * q;
      const bf16x8 a0 = *(const LAS bf16x8*)ap, a1 = *(const LAS bf16x8*)(ap + 32);
#pragma unroll
      for (int j = 0; j < 2; ++j) { const int tn = (F.wave & 1) * 2 + j; const LAS bf16_t* bp = KD + (16 * tn + l15) * GLS + 8 * q;
          f32x4 acc = {0.f, 0.f, 0.f, 0.f};
          acc = __builtin_amdgcn_mfma_f32_16x16x32_bf16(a0, *(const LAS bf16x8*)bp, acc, 0, 0, 0);
          acc = __builtin_amdgcn_mfma_f32_16x16x32_bf16(a1, *(const LAS bf16x8*)(bp + 32), acc, 0, 0, 0);
#pragma unroll
          for (int r = 0; r < 4; ++r) { const int t = 16 * tm + q * 4 + r, s = 16 * tn + l15; PP[t * GLS + s] = (bf16_t)f2bf(s <= t ? acc[r] : 0.f); } } }
    __syncthreads();
    f32x4 acc[4];
    {
#pragma unroll
      for (int tm = 0; tm < 4; ++tm) { const LAS bf16_t* pp = PP + (16 * tm + l15) * GLS + 8 * q; const LAS bf16_t* qp = QS + (16 * tm + l15) * GLS + 8 * q;
          f32x4 c4 = {0.f, 0.f, 0.f, 0.f};
          c4 = __builtin_amdgcn_mfma_f32_16x16x32_bf16(*(const LAS bf16x8*)pp, bv0, c4, 0, 0, 0);
          c4 = __builtin_amdgcn_mfma_f32_16x16x32_bf16(*(const LAS bf16x8*)(pp + 32), bv1, c4, 0, 0, 0);
          c4 = __builtin_amdgcn_mfma_f32_16x16x32_bf16(*(const LAS bf16x8*)qp, bs0, c4, 0, 0, 0);
          c4 = __builtin_amdgcn_mfma_f32_16x16x32_bf16(*(const LAS bf16x8*)(qp + 32), bs1, c4, 0, 0, 0);
          acc[tm] = c4; } }
    LAS float* OT = (LAS float*)(F.lds + GL_OT);
#pragma unroll
    for (int tm = 0; tm < 4; ++tm)
#pragma unroll
        for (int r = 0; r < 4; ++r) OT[(16 * tm + q * 4 + r) * GL_OTS + 16 * F.wave + l15] = acc[tm][r];
    __syncthreads();
    { const int t = F.tid >> 3, g = F.tid & 7;
      f32x4 o[4]; float sq = 0.f;
#pragma unroll
      for (int k = 0; k < 4; ++k) { o[k] = *(const LAS f32x4*)(OT + t * GL_OTS + 16 * g + 4 * k); sq += (o[k].x * o[k].x + o[k].y * o[k].y) + (o[k].z * o[k].z + o[k].w * o[k].w); }
      sq += dppf<0xB1>(sq); sq += dppf<0x4E>(sq); sq += dppf<0x141>(sq);
      const float rs = 1.0f / sqrtf(sq * (1.0f / 128.0f) + LN_EPS);
      const f32x4* nwp = (const f32x4*)(a.norm_w + h * 128 + 16 * g);
      u32x4 ow[2];
#pragma unroll
      for (int k = 0; k < 4; ++k) { const f32x4 nw = nwp[k]; const unsigned w0 = R.rg2[k >> 1][(k & 1) * 2], w1 = R.rg2[k >> 1][(k & 1) * 2 + 1];
          const float r0 = bflo(w0), r1 = bfhi(w0), r2 = bflo(w1), r3 = bfhi(w1);
          const float y0 = o[k].x * rs * nw.x * (r0 * sigmoidf_(r0)), y1 = o[k].y * rs * nw.y * (r1 * sigmoidf_(r1)), y2 = o[k].z * rs * nw.z * (r2 * sigmoidf_(r2)), y3 = o[k].w * rs * nw.w * (r3 * sigmoidf_(r3));
          ow[k >> 1][(k & 1) * 2] = pk2(y0, y1); ow[k >> 1][(k & 1) * 2 + 1] = pk2(y2, y3); }
      u32x4* op = (u32x4*)(OG + (size_t)(tok0 + t) * DM + h * 128 + 16 * g); op[0] = ow[0]; op[1] = ow[1]; }
    __syncthreads();
}
typedef GAS unsigned gu32;
#define RLX_AGENT __ATOMIC_RELAXED, __HIP_MEMORY_SCOPE_AGENT
#define XB_TMO      128
#define XB_XCNT(j)  (256  + 64 * (j))
#define XB_XSUB(j)  (1280 + 64 * (j))
#define XB_XGEN(j)  (2304 + 64 * (j))
#define XB_TOP      3328
#define XB_TOPGEN   3392
#define XCD_BAR_WORDS 3456
#define XB_SPIN_CAP (1u << 18)

__device__ __forceinline__ unsigned xb_ld(unsigned* p)              { return __hip_atomic_load(p, __ATOMIC_RELAXED, __HIP_MEMORY_SCOPE_AGENT); }
__device__ __forceinline__ unsigned xb_add(unsigned* p, unsigned v) { return __hip_atomic_fetch_add(p, v, __ATOMIC_RELAXED, __HIP_MEMORY_SCOPE_AGENT); }
__device__ __forceinline__ unsigned xb_xcc_id() { return (unsigned)__builtin_amdgcn_s_getreg((3 << 11) | 20) & 0xFu; }
#define XB_SPIN(cond, bar) do { unsigned _sp = 0; while (cond) { __builtin_amdgcn_s_sleep(1); \
    if ((++_sp & 255u) == 0u) { if (xb_ld(&(bar)[XB_TMO])) break; if (_sp > XB_SPIN_CAP) { atomicAdd(&(bar)[XB_TMO], 1u); break; } } } } while (0)

struct XcdBarrier {
    unsigned* bar; unsigned x;
    volatile LAS unsigned* st;
};

__device__ __forceinline__ XcdBarrier xcd_barrier_post(unsigned* bar, volatile LAS unsigned* st) {
    XcdBarrier b; b.bar = bar; b.x = xb_xcc_id(); b.st = st;
    if (threadIdx.x == 0) (void)xb_add(&bar[XB_XCNT(b.x)], 1u);
    return b;
}
__device__ __forceinline__ void xcd_barrier_complete(unsigned* bar, unsigned x, unsigned& nloc, unsigned& nx) {
    const unsigned G = gridDim.x * gridDim.y * gridDim.z;
    unsigned sum, cnt, mine, sp = 0u;
    for (;;) {
        sum = 0u; cnt = 0u; mine = 0u;
#pragma unroll
        for (unsigned j = 0; j < 16; ++j) { const unsigned c = xb_ld(&bar[XB_XCNT(j)]); sum += c; cnt += (c > 0u) ? 1u : 0u; mine = (j == x) ? c : mine; }
        if (sum == G) break;
        __builtin_amdgcn_s_sleep(1);
        if ((++sp & 255u) == 0u) { if (xb_ld(&bar[XB_TMO])) break; if (sp > XB_SPIN_CAP) { atomicAdd(&bar[XB_TMO], 1u); break; } }
    }
    nloc = mine > 0u ? mine : 1u; nx = cnt > 0u ? cnt : 1u;
}

__device__ __forceinline__ void xcd_barrier(const XcdBarrier& b) {
    asm volatile("s_waitcnt vmcnt(0)" ::: "memory");
    __syncthreads();
    if (threadIdx.x == 0) {
        unsigned* bar = b.bar;
        __builtin_amdgcn_s_waitcnt(0);
        unsigned nloc = b.st[0], nx = b.st[1];
        if (nloc == 0u) { xcd_barrier_complete(bar, b.x, nloc, nx); b.st[0] = nloc; b.st[1] = nx; }
        const unsigned old = xb_add(&bar[XB_XSUB(b.x)], 1u);
        const unsigned gen = old / nloc;
        if (old + 1u == (gen + 1u) * nloc) {
            __builtin_amdgcn_fence(__ATOMIC_RELEASE, "agent");
            asm volatile("s_waitcnt vmcnt(0)" ::: "memory");
            const unsigned og = xb_add(&bar[XB_TOP], 1u);
            const unsigned tg = og / nx;
            if (og + 1u == (tg + 1u) * nx) xb_add(&bar[XB_TOPGEN], 1u);
            else XB_SPIN(xb_ld(&bar[XB_TOPGEN]) == tg, bar);
            __builtin_amdgcn_fence(__ATOMIC_ACQUIRE, "agent");
            xb_add(&bar[XB_XGEN(b.x)], 1u);
            asm volatile("s_waitcnt vmcnt(0)" ::: "memory");
        } else {
            XB_SPIN(xb_ld(&bar[XB_XGEN(b.x)]) == gen, bar);
            __builtin_amdgcn_fence(__ATOMIC_ACQUIRE, "agent");
            asm volatile("s_waitcnt vmcnt(0)" ::: "memory");
        }
    }
    __syncthreads();
}

constexpr int ATS = 1032;
constexpr int P8_HIST = 64 * ATS * 2;
__device__ __forceinline__ void p8_phase(Frame& F, const Args& a) {
    const float* mod = (const float*)(a.ws + WS_MOD); bf16_t* H2 = (bf16_t*)(a.ws + WS_H2); const bf16_t* WR = (const bf16_t*)(a.ws + WS_WSM + 65536);
    float* X1 = a.out;
    unsigned* gcnt = (unsigned*)(a.ws + WS_CTL) + CW_CNT;     int* LIST = (int*)(a.ws + WS_LIST); float* WTOK = (float*)(a.ws + WS_GWT);     unsigned* SLOT = (unsigned*)(a.ws + WS_SLOT);
    LAS bf16_t* AT = (LAS bf16_t*)F.lds; LAS float* LG = (LAS float*)F.lds; LAS int* HIST = (LAS int*)(F.lds + P8_HIST); LAS int* BASE = HIST + 64;
    for (int blk = F.bid; blk < NTOK / 64; blk += F.G) {
        if (F.tid < 64) HIST[F.tid] = 0;
        int ln_ = F.lane; asm volatile("" : "+v"(ln_)); const float rb = a.r_bias[ln_];
        {
            const int m0 = blk * 64 + F.wave * 8, b = m0 >> 11;
            f32x4 va[8][4];
#pragma unroll
            for (int h4 = 0; h4 < 2; ++h4) { u32x2 gm[4][4];
#pragma unroll
                for (int i = 0; i < 4; ++i)
#pragma unroll
                    for (int j = 0; j < 4; ++j) { va[4 * h4 + i][j] = __builtin_nontemporal_load((const f32x4*)(a.x + (size_t)(m0 + 4 * h4 + i) * DM) + F.lane + 64 * j);
                        gm[i][j] = *((const u32x2*)((const bf16_t*)(a.out + (size_t)(m0 + 4 * h4 + i) * DM)) + F.lane + 64 * j); }
#pragma unroll
                for (int i = 0; i < 4; ++i)
#pragma unroll
                    for (int j = 0; j < 4; ++j) va[4 * h4 + i][j] = va[4 * h4 + i][j] * DN_ALPHA + (f32x4){bflo(gm[i][j].x), bfhi(gm[i][j].x), bflo(gm[i][j].y), bfhi(gm[i][j].y)}; }
            f32x4 lg[4], lb[4], sh[4], sc[4];
#pragma unroll
            for (int j = 0; j < 4; ++j) { lg[j] = *((const f32x4*)a.ln1_g + F.lane + 64 * j); lb[j] = *((const f32x4*)a.ln1_b + F.lane + 64 * j);
                sh[j] = *((const f32x4*)(mod + b * 6144 + 3 * DM) + F.lane + 64 * j); sc[j] = *((const f32x4*)(mod + b * 6144 + 4 * DM) + F.lane + 64 * j) + 1.0f; }
#pragma unroll
            for (int i = 0; i < 8; ++i) {
                const int lr = F.wave * 8 + i, m = m0 + i;
                f32x4 v[4]; float s = 0.f;
#pragma unroll
                for (int j = 0; j < 4; ++j) { v[j] = va[i][j]; s += (v[j].x + v[j].y) + (v[j].z + v[j].w); }
                float mean = wave_sum(s) * (1.f / DM), s2 = 0.f;
#pragma unroll
                for (int j = 0; j < 4; ++j) { v[j] = v[j] - mean; s2 += (v[j].x * v[j].x + v[j].y * v[j].y) + (v[j].z * v[j].z + v[j].w * v[j].w); }
                float rstd = 1.f / sqrtf(wave_sum(s2) * (1.f / DM) + LN_EPS);
                s = 0.f;
#pragma unroll
                for (int j = 0; j < 4; ++j) { v[j] = v[j] * rstd * lg[j] + lb[j]; { u32x2 xw; xw.x = pk2(v[j].x, v[j].y); xw.y = pk2(v[j].z, v[j].w); *((u32x2*)(X1 + (size_t)m * DM) + F.lane + 64 * j) = xw; } s += (v[j].x + v[j].y) + (v[j].z + v[j].w); }
                mean = wave_sum(s) * (1.f / DM); s2 = 0.f;
#pragma unroll
                for (int j = 0; j < 4; ++j) { v[j] = v[j] - mean; s2 += (v[j].x * v[j].x + v[j].y * v[j].y) + (v[j].z * v[j].z + v[j].w * v[j].w); }
                rstd = 1.f / sqrtf(wave_sum(s2) * (1.f / DM) + LN_EPS);
                unsigned* o8 = (unsigned*)((unsigned char*)H2 + (size_t)m * DM) + F.lane; LAS u32x2* l8 = (LAS u32x2*)(AT + lr * ATS) + F.lane;
#pragma unroll
                for (int j = 0; j < 4; ++j) { const f32x4 y = v[j] * rstd * sc[j] + sh[j]; u32x2 w; w.x = pk2(y.x, y.y); w.y = pk2(y.z, y.w); o8[64 * j] = pack4_e4m3(y.x, y.y, y.z, y.w, F8H_SCALE); l8[64 * j] = w; }
            }
        }
        __syncthreads();
        int lb_ = F.lane; asm volatile("" : "+v"(lb_));
        const int l15 = lb_ & 15, q = lb_ >> 4, tn = F.wave & 3, tm0 = (F.wave >> 2) * 2;
        f32x4 lg0 = {0.f, 0.f, 0.f, 0.f}, lg1 = {0.f, 0.f, 0.f, 0.f};
        { const LAS bf16_t* ap0 = AT + (16 * tm0 + l15) * ATS + 8 * q; const LAS bf16_t* ap1 = ap0 + 16 * ATS; const bf16_t* bp = WR + (size_t)(16 * tn + l15) * DM + 8 * q;
#pragma unroll 8
          for (int k = 0; k < DM; k += 32) { const bf16x8 bv = *(const bf16x8*)(bp + k);
              lg0 = __builtin_amdgcn_mfma_f32_16x16x32_bf16(*(const LAS bf16x8*)(ap0 + k), bv, lg0, 0, 0, 0);
              lg1 = __builtin_amdgcn_mfma_f32_16x16x32_bf16(*(const LAS bf16x8*)(ap1 + k), bv, lg1, 0, 0, 0); } }
        __syncthreads();
#pragma unroll
        for (int r = 0; r < 4; ++r) { const int e0 = 16 * tn + l15; LG[(16 * tm0 + q * 4 + r) * 64 + e0] = lg0[r]; LG[(16 * (tm0 + 1) + q * 4 + r) * 64 + e0] = lg1[r]; }
        __syncthreads();
        const int e = F.lane;
        bool sel[8]; int ploc[8], rnk[8]; float wgt[8];
#pragma unroll
        for (int i = 0; i < 8; ++i) {
            const int lr = F.wave * 8 + i;
            const float score = sigmoidf_(LG[lr * 64 + e]); const float sv = score + rb;
            const float m1 = grp8_max(sv);
            const int i1 = grp8_min((sv == m1) ? e : 64);
            const float m2 = grp8_max((e == i1) ? -INFINITY : sv);
            const float gs = m1 + m2; const int g = e >> 3;
            int grank = 0;
#pragma unroll
            for (int j = 0; j < 8; ++j) { const float o = __builtin_bit_cast(float, __builtin_amdgcn_readlane(__builtin_bit_cast(int, gs), 8 * j)); grank += (o > gs || (o == gs && j < g)) ? 1 : 0; }
            const float sm = (grank < 4) ? sv : -INFINITY;
            int rank = 64; { float cur = sm;
#pragma unroll
              for (int k = 0; k < 8; ++k) { const float mx = wave_max(cur); const int idx = (int)__builtin_ctzll(__builtin_amdgcn_ballot_w64(cur == mx)); if (e == idx) { rank = k; cur = -INFINITY; } } }
            const bool s_ = rank < 8;
            const float wsum = wave_sum(s_ ? score : 0.f);
            sel[i] = s_; rnk[i] = rank; wgt[i] = score / wsum * ROUTED_SCALE;
            ploc[i] = s_ ? __hip_atomic_fetch_add(&HIST[e], 1, __ATOMIC_RELAXED, __HIP_MEMORY_SCOPE_WORKGROUP) : 0;
        }
        __syncthreads();
        { int t_ = F.tid; asm volatile("" : "+v"(t_));
          if (t_ < 64) BASE[t_] = (int)__hip_atomic_fetch_add(gcnt + 64 * t_, (unsigned)HIST[t_], __ATOMIC_RELAXED, __HIP_MEMORY_SCOPE_AGENT); }
        __syncthreads();
        const int base = BASE[e];
#pragma unroll
        for (int i = 0; i < 8; ++i) if (sel[i]) { const int m = blk * 64 + F.wave * 8 + i, p = base + ploc[i];
            LIST[(size_t)e * ECAP + p] = m; WTOK[(size_t)m * 8 + rnk[i]] = wgt[i]; SLOT[(size_t)m * 8 + rnk[i]] = ((unsigned)e << 16) | (unsigned)p; }
        __syncthreads();
    }
}

constexpr int TB_TE = TAB_OFF, TB_TP = TAB_OFF + 4096, TB_CNT = TAB_OFF + 8192, TB_YOFF = TAB_OFF + 8192 + 512, TB_NT = TAB_OFF + 8192 + 1024;
__device__ __forceinline__ int moe_tables(Frame& F, const Args& a) {
    const unsigned* gcnt = (const unsigned*)(a.ws + WS_CTL) + CW_CNT;
    LAS int* TE = (LAS int*)(F.lds + TB_TE); LAS int* TP = (LAS int*)(F.lds + TB_TP); LAS int* CNT = (LAS int*)(F.lds + TB_CNT); LAS int* YOFF = (LAS int*)(F.lds + TB_YOFF); LAS int* NT = (LAS int*)(F.lds + TB_NT);
    if (F.wave == 0) {
        const int e = F.lane;
        const int c = (int)__hip_atomic_load(gcnt + 64 * e, __ATOMIC_RELAXED, __HIP_MEMORY_SCOPE_AGENT), nt = (c + 255) >> 8;
        int st = nt, sy = c;
#pragma unroll
        for (int o = 1; o < 64; o <<= 1) { const int pt = __shfl_up(st, o), py = __shfl_up(sy, o); if (e >= o) { st += pt; sy += py; } }
        const int t0 = st - nt, y0 = sy - c;
        CNT[e] = c; YOFF[e] = y0;
        for (int j = 0; j < nt; ++j) { TE[t0 + j] = e; TP[t0 + j] = j * 256; }
        const int tsh = __shfl(st, 63), ysh = __shfl(sy, 63);
        TE[tsh + e] = NEXP; TP[tsh + e] = e * 256;
        if (e == 0) { CNT[NEXP] = NTOK; YOFF[NEXP] = ysh; NT[0] = tsh + NTOK / 256; }
    }
    __syncthreads();
    return __builtin_amdgcn_readfirstlane(NT[0]);
}

__device__ __forceinline__ void p11_phase(Frame& F, const Args& a, float* dst) {
    const float* mod = (const float*)(a.ws + WS_MOD); const unsigned char* YS = (const unsigned char*)(a.ws + WS_YS); const unsigned* SLOT = (const unsigned*)(a.ws + WS_SLOT); const float* WTOK = (const float*)(a.ws + WS_GWT);
    LAS int* YOFF = (LAS int*)(F.lds + TB_YOFF);
    const int gw = F.bid * NWAVES + F.wave, NGW = F.G * NWAVES;
    const int cb = 256 * (F.lane >> 4) + 32 * ((F.lane >> 2) & 3) + 8 * (F.lane & 3);
    typedef float f32x2v __attribute__((ext_vector_type(2)));
    f32x4 lng[2][2], lnb[2][2];
#pragma unroll
    for (int g = 0; g < 2; ++g)
#pragma unroll
        for (int h = 0; h < 2; ++h) { lng[g][h] = *(const f32x4*)(a.ln2_g + cb + 128 * g + 4 * h); lnb[g][h] = *(const f32x4*)(a.ln2_b + cb + 128 * g + 4 * h); }
    u32x4 sn[2][2]; f32x4 wn[2][2];
#define P11_PF(mm0) do { _Pragma("unroll") for (int t = 0; t < 2; ++t) { const int m_ = (mm0) + t * NGW; if (m_ < NTOK) { sn[t][0] = *(const u32x4*)(SLOT + (size_t)m_ * 8); sn[t][1] = *(const u32x4*)(SLOT + (size_t)m_ * 8 + 4); \
            wn[t][0] = *(const f32x4*)(WTOK + (size_t)m_ * 8); wn[t][1] = *(const f32x4*)(WTOK + (size_t)m_ * 8 + 4); } } } while (0)
    P11_PF(gw);
    for (int m0 = gw; m0 < NTOK; m0 += 2 * NGW) {
        u32x4 yv[2][9], xv[2][2]; float wk[2][9];
        u32x4 sc_[2][2]; f32x4 wc_[2][2];
#pragma unroll
        for (int t = 0; t < 2; ++t) { sc_[t][0] = sn[t][0]; sc_[t][1] = sn[t][1]; wc_[t][0] = wn[t][0]; wc_[t][1] = wn[t][1]; }
        P11_PF(m0 + 2 * NGW);
#pragma unroll
        for (int t = 0; t < 2; ++t) { const int m = m0 + t * NGW;
            const u32x4 s0 = sc_[t][0], s1 = sc_[t][1];
            const unsigned sl[8] = {s0.x, s0.y, s0.z, s0.w, s1.x, s1.y, s1.z, s1.w};
            const f32x4 w0 = wc_[t][0], w1 = wc_[t][1];
            wk[t][0] = w0.x; wk[t][1] = w0.y; wk[t][2] = w0.z; wk[t][3] = w0.w; wk[t][4] = w1.x; wk[t][5] = w1.y; wk[t][6] = w1.z; wk[t][7] = w1.w; wk[t][8] = 1.0f;
            yv[t][8] = *((const u32x4*)(YS + (size_t)(NTOK * 8 + m) * 1024) + F.lane);
#pragma unroll
            for (int k = 0; k < 8; ++k) { const int row = YOFF[sl[k] >> 16] + (int)(sl[k] & 0xffffu); yv[t][k] = *((const u32x4*)(YS + (size_t)row * 1024) + F.lane); }
            const bf16_t* xrow = (const bf16_t*)(a.out + (size_t)m * DM);
            xv[t][0] = *(const u32x4*)(xrow + cb); xv[t][1] = *(const u32x4*)(xrow + cb + 128); }
#pragma unroll
        for (int t = 0; t < 2; ++t) { const int m = m0 + t * NGW, b = m >> 11;
            float f[16];
#pragma unroll
            for (int i = 0; i < 16; ++i) f[i] = 0.f;
#pragma unroll
            for (int k = 8; k >= 0; --k)
#pragma unroll
                for (int d = 0; d < 4; ++d) { const f32x2v lo = __builtin_amdgcn_cvt_pk_f32_fp8((int)yv[t][k][d], false), hi = __builtin_amdgcn_cvt_pk_f32_fp8((int)yv[t][k][d], true);
                    f[4 * d] += wk[t][k] * lo.x; f[4 * d + 1] += wk[t][k] * lo.y; f[4 * d + 2] += wk[t][k] * hi.x; f[4 * d + 3] += wk[t][k] * hi.y; }
            const u32x4 xv0 = xv[t][0], xv1 = xv[t][1];
            float x1[16] = {bflo(xv0.x), bfhi(xv0.x), bflo(xv0.y), bfhi(xv0.y), bflo(xv0.z), bfhi(xv0.z), bflo(xv0.w), bfhi(xv0.w),
                            bflo(xv1.x), bfhi(xv1.x), bflo(xv1.y), bfhi(xv1.y), bflo(xv1.z), bfhi(xv1.z), bflo(xv1.w), bfhi(xv1.w)};
            float v[16]; float s = 0.f;
#pragma unroll
            for (int g = 0; g < 2; ++g)
#pragma unroll
                for (int h = 0; h < 2; ++h) { const f32x4 g2 = *(const f32x4*)(mod + b * 6144 + 5 * DM + cb + 128 * g + 4 * h);
#pragma unroll
                    for (int j = 0; j < 4; ++j) { const int i = 8 * g + 4 * h + j; v[i] = x1[i] * DN_ALPHA + g2[j] * (f[i] * pg8::YS_INV); s += v[i]; } }
            const float mean = wave_sum(s) * (1.f / DM); float s2 = 0.f;
#pragma unroll
            for (int i = 0; i < 16; ++i) { v[i] -= mean; s2 += v[i] * v[i]; }
            const float rstd = 1.f / sqrtf(wave_sum(s2) * (1.f / DM) + LN_EPS);
#pragma unroll
            for (int g = 0; g < 2; ++g)
#pragma unroll
                for (int h = 0; h < 2; ++h) { const int c = cb + 128 * g + 4 * h; const f32x4 gg = lng[g][h], be = lnb[g][h];
                    f32x4 o;
#pragma unroll
                    for (int j = 0; j < 4; ++j) o[j] = v[8 * g + 4 * h + j] * rstd * gg[j] + be[j];
                    *(f32x4*)(dst + (size_t)m * DM + c) = o; }
        }
    }
#undef P11_PF
}

template <int P> __device__ __forceinline__ void run_phase(Frame& F, const Args& a) {
    unsigned char* ws = a.ws;
    if constexpr (P == 0) { p0_phase(F, a); }
    if constexpr (P == 1) { p1_phase(F, a); }
    if constexpr (P == 2) {
        glr_stage(F, a); __syncthreads();
        for (int t = F.bid * NWAVES + F.wave; t < NTOK / 16; t += F.G * NWAVES) glr_tile(F, a, t);
        __syncthreads();
        { pg8::Gemm g{(const bf16_t*)(ws + WS_H1), (const bf16_t*)(ws + WS_WIN), NTOK, PW, DM}; pg8::StaticOrder S; S.init(NTOK, PW, F.G, F.bid);
          pg8::EpiStore E{(bf16_t*)(ws + WS_PROJ), PW, true};
          pg8::gemm_phase<pg8::EpiStore, pg8::StaticOrder, true, pg8::NoGather>(F.lds, g, S, E, pg8::NoGather{}); }
        { pg8::Gemm g{(const bf16_t*)(ws + WS_WV), (const bf16_t*)(ws + WS_H1), 1024, NTOK, DM}; pg8::StaticOrder S; S.init(1024, NTOK, F.G, F.bid);
          pg8::EpiVT E{(bf16_t*)(ws + WS_VT)};
          pg8::gemm_phase<pg8::EpiVT, pg8::StaticOrder, true, pg8::NoGather>(F.lds, g, S, E, pg8::NoGather{}); }
    }
    if constexpr (P == 3) {
        const int gw = F.bid * NWAVES + F.wave, NGW = F.G * NWAVES;
        if ((F.G & 7) == 0 && (F.G >> 3) * NWAVES * 2 * 8 == 4096) cv_phase(F, a);
        { G1In R0, R1; int u = F.bid; if (u < 1024) g1_load(F, a, u, R0);
          for (; u < 1024; u += F.G) { const int un = u + F.G; if (un < 1024) g1_load(F, a, un, R1); gla_g1(F, a, u, R0); R0 = R1; } }
        int cit = gw;
        if ((F.G & 7) == 0 && (F.G >> 3) * NWAVES * 2 * 8 == 4096) {
            cit = MOE_ITEMS;
            const int lw = (F.bid >> 3) * NWAVES + F.wave, bh = (F.bid & 7) * 8 + (lw >> 5), qb = lw & 31, qb0 = ((F.bid >> 3) * NWAVES) & 31;
            sb_unit_shared(F, bh, qb, qb0 + 7, (const bf16_t*)(ws + WS_PROJ), (const bf16_t*)(ws + WS_VT), (bf16_t*)(ws + WS_OCAT), a, cit, NGW);
            sb_unit_shared(F, bh, 63 - qb, 63 - qb0, (const bf16_t*)(ws + WS_PROJ), (const bf16_t*)(ws + WS_VT), (bf16_t*)(ws + WS_OCAT), a, cit, NGW);
        } else
        for (int u = gw; u < 2048; u += NGW) {
            sb_unit(u >> 6, u & 63, (const bf16_t*)(ws + WS_PROJ), (const bf16_t*)(ws + WS_VT), (bf16_t*)(ws + WS_OCAT), F.lane, a, cit, NGW, F.lds + F.wave * SB_LDS);
            const int u2 = 4095 - u;
            sb_unit(u2 >> 6, u2 & 63, (const bf16_t*)(ws + WS_PROJ), (const bf16_t*)(ws + WS_VT), (bf16_t*)(ws + WS_OCAT), F.lane, a, cit, NGW, F.lds + F.wave * SB_LDS);
        }
        for (; cit < MOE_ITEMS; cit += NGW) { f32x4 cv[16]; moe_item_load(a, cit, F.lane, cv); moe_item_store(a, cit, F.lane, cv); }
    }
    if constexpr (P == 4) { gla_scan(F, a); }
    if constexpr (P == 5) {
        G3In R0, R1;
        int u = F.bid; if (u < 1024) g3_load(F, a, u, R0);
        for (; u < 1024; u += F.G) { const int un = u + F.G; if (un < 1024) g3_load(F, a, un, R1); gla_g3(F, a, u, R0); R0 = R1; }
    }
    if constexpr (P == 6) {
        pg8::StaticOrder S; S.init(NTOK, DM, F.G, F.bid);
        pg8::Gemm g{(const bf16_t*)(ws + WS_OCAT), (const bf16_t*)(ws + WS_WCAT), NTOK, DM, DM}; pg8::EpiBranch E{(const bf16_t*)(ws + WS_PROJ), (bf16_t*)(ws + WS_Y)};
        pg8::gemm_phase<pg8::EpiBranch, pg8::StaticOrder, true, pg8::NoGather>(F.lds, g, S, E, pg8::NoGather{});
    }
    if constexpr (P == 7) {
        pg8::Gemm g{(const bf16_t*)(ws + WS_Y), (const bf16_t*)(ws + WS_WOUT), NTOK, DM, DM}; pg8::StaticOrder S; S.init(NTOK, DM, F.G, F.bid);
        pg8::EpiOut E{(const float*)(ws + WS_MOD), (bf16_t*)a.out};
        pg8::gemm_phase<pg8::EpiOut, pg8::StaticOrder, true, pg8::NoGather>(F.lds, g, S, E, pg8::NoGather{});
    }
    if constexpr (P == 8) { p8_phase(F, a); }
    if constexpr (P == 9) {
        const int ntiles = moe_tables(F, a);
        pg8::MoeTab tb{(const LAS int*)(F.lds + TB_TE), (const LAS int*)(F.lds + TB_TP), (const LAS int*)(F.lds + TB_CNT), (const LAS int*)(F.lds + TB_YOFF)};
        pg8::Gemm g{(const bf16_t*)(ws + WS_H2), (const bf16_t*)(ws + WS_WGU), NTOK, 512, DM / 2};
        pg8::MoeOrder S{ntiles * 2, 2, F.G, F.bid, tb.tile_e};
        pg8::EpiMoe1 E{ws + WS_ACT, 1.0f / (F8W_SCALE * F8H_SCALE)};
        pg8::MoeGather GA{tb, (const int*)(ws + WS_LIST)};
        pg8::gemm_phase<pg8::EpiMoe1, pg8::MoeOrder, true, pg8::MoeGather, true>(F.lds, g, S, E, GA);
    }
    if constexpr (P == 10) {
        const int ntiles = __builtin_amdgcn_readfirstlane(*(const LAS int*)(F.lds + TB_NT));
        pg8::MoeTab tb{(const LAS int*)(F.lds + TB_TE), (const LAS int*)(F.lds + TB_TP), (const LAS int*)(F.lds + TB_CNT), (const LAS int*)(F.lds + TB_YOFF)};
        pg8::Gemm g{(const bf16_t*)(ws + WS_ACT), (const bf16_t*)(ws + WS_WDN), NTOK, DM, 256 / 2};
        pg8::MoeOrder S{ntiles * 4, 4, F.G, F.bid, tb.tile_e};
        pg8::EpiMoe2 E{tb, ws + WS_YS, pg8::YS_SCALE / (F8W_SCALE * F8A_SCALE)};
        pg8::gemm_phase<pg8::EpiMoe2, pg8::MoeOrder, true, pg8::NoGather, true>(F.lds, g, S, E, pg8::NoGather{});
    }
    if constexpr (P == 11) { p11_phase(F, a, a.out); }
}
#define MK_FRAME() Frame F; { int t_ = threadIdx.x; asm volatile("" : "+v"(t_)); F.lds = (LAS unsigned char*)lds_raw; F.tid = t_; F.lane = t_ & 63; F.wave = __builtin_amdgcn_readfirstlane(t_ >> 6); F.G = gridDim.x; F.bid = blockIdx.x; }

extern __shared__ __attribute__((aligned(16))) unsigned char lds_raw[];
template <int P> __global__ void __launch_bounds__(NTHR, 2) fwd_ph(Args a) { MK_FRAME(); run_phase<P>(F, a); }

#ifndef N_LAUNCHES
#define N_LAUNCHES 1
#endif
#if N_LAUNCHES == 1
__global__ void __launch_bounds__(NTHR, 2) fwd_all(Args a_unused) {
    volatile LAS unsigned* bst = (volatile LAS unsigned*)((LAS unsigned char*)lds_raw + LDS_BYTES - 64);
    if (threadIdx.x < 2) bst[threadIdx.x] = 0u;
    __syncthreads();
    XcdBarrier bar;
    { auto kp0 = __builtin_amdgcn_kernarg_segment_ptr(); bar = xcd_barrier_post((unsigned*)(((const Args*)kp0)->ws + WS_CTL) + CW_BAR, bst); }
#define PH(k) { MK_FRAME(); auto kp_ = __builtin_amdgcn_kernarg_segment_ptr(); asm volatile("" : "+s"(kp_)); run_phase<k>(F, *(const Args*)kp_); }
    PH(0) xcd_barrier(bar);
    PH(1) xcd_barrier(bar); PH(2) xcd_barrier(bar); PH(3) xcd_barrier(bar); PH(4) xcd_barrier(bar); PH(5) xcd_barrier(bar);
    PH(6) xcd_barrier(bar); PH(7) xcd_barrier(bar); PH(8) xcd_barrier(bar); PH(9) xcd_barrier(bar); PH(10) xcd_barrier(bar); PH(11)
#undef PH
}
#endif

template <int P> static void launch_ph(int grid, const Args& a, hipStream_t stream) {
    static bool attr = false;
    if (!attr) { (void)hipFuncSetAttribute((const void*)fwd_ph<P>, hipFuncAttributeMaxDynamicSharedMemorySize, LDS_BYTES); attr = true; }
    hipLaunchKernelGGL(fwd_ph<P>, dim3(grid), dim3(NTHR), LDS_BYTES, stream, a);
}
extern "C" void kernel_launch(void* const* d_in, const int* in_sizes, int n_in, void* d_out, int out_size, void* d_ws, size_t ws_size, hipStream_t stream) {
    static int grid = 0;
    if (grid == 0) {
        if (n_in != 21 || out_size != NTOK * DM || ws_size < WS_END) { fprintf(stderr, "kernel_launch: unexpected shapes (n_in %d out %d ws %zu)\n", n_in, out_size, ws_size); grid = -1; return; }
        int dev = 0, cus = 0, per_cu = 0;
        (void)hipGetDevice(&dev); (void)hipDeviceGetAttribute(&cus, hipDeviceAttributeMultiprocessorCount, dev);
#if N_LAUNCHES == 1
        if (hipFuncSetAttribute((const void*)fwd_all, hipFuncAttributeMaxDynamicSharedMemorySize, LDS_BYTES) != hipSuccess) { fprintf(stderr, "kernel_launch: hipFuncSetAttribute failed\n"); grid = -1; return; }
        (void)hipOccupancyMaxActiveBlocksPerMultiprocessor(&per_cu, (const void*)fwd_all, NTHR, LDS_BYTES);
#else
        per_cu = 1;
#endif
        (void)hipGetLastError();
        if (per_cu < 1) { fprintf(stderr, "kernel_launch: occupancy query reports %d blocks per CU\n", per_cu); per_cu = 1; }
        grid = cus;
        fprintf(stderr, "kernel_launch: cus %d per_cu %d grid %d\n", cus, per_cu, grid);
    }
    if (grid < 0) return;
    (void)hipMemsetAsync((char*)d_ws + WS_CTL + (size_t)CW_BAR * 4, 0, (size_t)(CW_CNT + 64 * 64 - CW_BAR) * 4, stream);
    Args a{};
    const float** ap = (const float**)&a;
    for (int i = 0; i < 21; ++i) ap[i] = (const float*)d_in[i];
    a.out = (float*)d_out; a.ws = (unsigned char*)d_ws;
#if N_LAUNCHES == 1
    {
        void* args[] = {&a};
        hipError_t e = hipLaunchCooperativeKernel((const void*)fwd_all, dim3(grid), dim3(NTHR), args, LDS_BYTES, stream);
        if (e != hipSuccess) fprintf(stderr, "kernel_launch: cooperative launch failed: %s\n", hipGetErrorString(e));
    }
#else
    {
        launch_ph<0>(grid, a, stream); launch_ph<1>(grid, a, stream); launch_ph<2>(grid, a, stream); launch_ph<3>(grid, a, stream);
        launch_ph<4>(grid, a, stream); launch_ph<5>(grid, a, stream); launch_ph<6>(grid, a, stream); launch_ph<7>(grid, a, stream);
        launch_ph<8>(grid, a, stream); launch_ph<9>(grid, a, stream); launch_ph<10>(grid, a, stream); launch_ph<11>(grid, a, stream);
    }
#endif
}
```
